# Optimizing an MI355X kernel written in HIP

```python
import math
import jax, jax.numpy as jnp
from jax import lax
import numpy as np

D_MODEL = 1024
BATCH = 16
SEQ = 2048
DEPTH = 1

SSM_GROUP = 16
SSM_STATE = 64
SSM_WIDTH = D_MODEL // 2
SSM_GROUPS = SSM_WIDTH // SSM_GROUP
HEAD_DIM = 64
ATTN_PATTERNS = ((128, 1), (512, 4), (2048, 16))
N_PATTERNS = len(ATTN_PATTERNS)
HEADS_PER_PATTERN = (D_MODEL // 2) // HEAD_DIM
N_ATTN_HEADS = N_PATTERNS * HEADS_PER_PATTERN
ATTN_WIDTH = N_ATTN_HEADS * HEAD_DIM
ATTN_OUT = HEADS_PER_PATTERN * HEAD_DIM
BLOCK = 128
N_IN = SSM_WIDTH + 3 * ATTN_WIDTH + 2 * D_MODEL
D_FF = 2816
CONV_WIDTH = 3
EPS = 1e-6

kernel_name = "hybrid_s5_dilated_attn_convffn"


def rmsnorm(t, g):
    tf = t.astype(jnp.float32)
    return tf * lax.rsqrt(jnp.mean(tf * tf, axis=-1, keepdims=True) + EPS) * g.astype(jnp.float32)


def alibi_slopes():
    i = np.arange(1, N_ATTN_HEADS + 1, dtype=np.float32)
    s = np.exp2(-8.0 * i / N_ATTN_HEADS).astype(np.float32)
    return jnp.asarray(s.reshape(HEADS_PER_PATTERN, N_PATTERNS).T)


def s5_scan(u, lam_re, lam_im, log_dt, b_re, b_im, c_re, c_im, d_skip):
    bsz, l, _ = u.shape
    u = u.astype(jnp.float32).reshape(bsz, l, SSM_GROUPS, SSM_GROUP)
    dt = jnp.exp(log_dt.astype(jnp.float32))[:, None]
    lr = lam_re.astype(jnp.float32)
    li = lam_im.astype(jnp.float32)
    mag = jnp.exp(lr * dt)
    ar = mag * jnp.cos(li * dt)
    ai = mag * jnp.sin(li * dt)
    den = lr * lr + li * li
    cr = ((ar - 1.0) * lr + ai * li) / den
    ci = (ai * lr - (ar - 1.0) * li) / den
    br = b_re.astype(jnp.float32)
    bi = b_im.astype(jnp.float32)
    bbar_re = cr[..., None] * br - ci[..., None] * bi
    bbar_im = cr[..., None] * bi + ci[..., None] * br
    bu_re = jnp.einsum('blgc,gpc->lbgp', u, bbar_re)
    bu_im = jnp.einsum('blgc,gpc->lbgp', u, bbar_im)
    a_re = jnp.broadcast_to(ar, (l, 1, SSM_GROUPS, SSM_STATE))
    a_im = jnp.broadcast_to(ai, (l, 1, SSM_GROUPS, SSM_STATE))

    def combine(e1, e2):
        a1r, a1i, b1r, b1i = e1
        a2r, a2i, b2r, b2i = e2
        return (a2r * a1r - a2i * a1i,
                a2r * a1i + a2i * a1r,
                a2r * b1r - a2i * b1i + b2r,
                a2r * b1i + a2i * b1r + b2i)

    _, _, x_re, x_im = lax.associative_scan(combine, (a_re, a_im, bu_re, bu_im), axis=0)
    y = (jnp.einsum('gcp,lbgp->blgc', c_re.astype(jnp.float32), x_re)
         - jnp.einsum('gcp,lbgp->blgc', c_im.astype(jnp.float32), x_im))
    return y.reshape(bsz, l, SSM_WIDTH) + d_skip.astype(jnp.float32) * u.reshape(bsz, l, SSM_WIDTH)


def dilated_window_attention(q, k, v, slopes, window, dilation):
    b, l, h, dh = q.shape
    n = l // dilation
    reach = window // dilation
    nb = -(-n // BLOCK)
    n_pad = nb * BLOCK

    def strided(t):
        t = t.reshape(b, n, dilation, h, dh).transpose(0, 2, 1, 3, 4)
        t = jnp.pad(t, ((0, 0), (0, 0), (0, n_pad - n), (0, 0), (0, 0)))
        return t.reshape(b, dilation, nb, BLOCK, h, dh)

    def with_prev(t):
        prev = jnp.pad(t, ((0, 0), (0, 0), (1, 0), (0, 0), (0, 0), (0, 0)))[:, :, :-1]
        return jnp.concatenate([prev, t], axis=3)

    qb = strided(q)
    kc = with_prev(strided(k))
    vc = with_prev(strided(v)).astype(jnp.float32)
    s = jnp.einsum('brnqhd,brnkhd->brnhqk', qb, kc).astype(jnp.float32)
    qi = jnp.arange(BLOCK)[:, None]
    ki = jnp.arange(2 * BLOCK)[None, :]
    delta = qi + BLOCK - ki
    key_idx = jnp.arange(nb)[:, None] * BLOCK - BLOCK + jnp.arange(2 * BLOCK)[None, :]
    valid = ((delta >= 0) & (delta <= reach))[None] & (key_idx >= 0)[:, None, :]
    bias = -slopes.astype(jnp.float32)[:, None, None] * (delta * dilation).astype(jnp.float32)[None]
    s = jnp.where(valid[None, None, :, None], s + bias[None, None, None], -jnp.inf)
    m = jnp.max(s, axis=-1, keepdims=True)
    p = jnp.exp(s - m)
    den = jnp.sum(p, axis=-1, keepdims=True)
    o = jnp.einsum('brnhqk,brnkhd->brnqhd', p, vc) / jnp.swapaxes(den, 3, 4)
    lse = jnp.swapaxes((m + jnp.log(den))[..., 0], 3, 4)
    o = o.reshape(b, dilation, n_pad, h, dh)[:, :, :n].transpose(0, 2, 1, 3, 4).reshape(b, l, h, dh)
    lse = lse.reshape(b, dilation, n_pad, h)[:, :, :n].transpose(0, 2, 1, 3).reshape(b, l, h)
    return o, lse


def causal_dwconv(t, w, bias):
    f = t.shape[-1]
    y = lax.conv_general_dilated(
        t.astype(jnp.float32), w.astype(jnp.float32)[:, None, :],
        window_strides=(1,), padding=[(w.shape[0] - 1, 0)],
        dimension_numbers=('NWC', 'WIO', 'NWC'), feature_group_count=f)
    return y + bias.astype(jnp.float32)


def setup_inputs(seed: int = 0) -> dict:
    key = jax.random.key(seed)
    ks = jax.random.split(key, 24)
    f32 = jnp.float32

    def nrm(k, shape, scale):
        return jax.random.normal(k, shape, f32) * scale

    gp = (DEPTH, SSM_GROUPS, SSM_STATE)
    return {
        'x': nrm(ks[0], (BATCH, SEQ, D_MODEL), 1.0),
        'norm_mix_g': 1.0 + nrm(ks[1], (DEPTH, D_MODEL), 0.02),
        'w_in': nrm(ks[2], (DEPTH, D_MODEL, N_IN), D_MODEL ** -0.5),
        'ssm_lambda_re': -0.5 * jnp.exp(nrm(ks[3], gp, 0.05)),
        'ssm_lambda_im': jnp.broadcast_to(jnp.pi * jnp.arange(SSM_STATE, dtype=f32), gp) + nrm(ks[4], gp, 0.01),
        'ssm_log_dt': jax.random.uniform(ks[5], (DEPTH, SSM_GROUPS), f32, math.log(1e-3), math.log(1e-1)),
        'ssm_b_re': nrm(ks[6], (DEPTH, SSM_GROUPS, SSM_STATE, SSM_GROUP), (2 * SSM_GROUP) ** -0.5),
        'ssm_b_im': nrm(ks[7], (DEPTH, SSM_GROUPS, SSM_STATE, SSM_GROUP), (2 * SSM_GROUP) ** -0.5),
        'ssm_c_re': nrm(ks[8], (DEPTH, SSM_GROUPS, SSM_GROUP, SSM_STATE), SSM_STATE ** -0.5),
        'ssm_c_im': nrm(ks[9], (DEPTH, SSM_GROUPS, SSM_GROUP, SSM_STATE), SSM_STATE ** -0.5),
        'ssm_d': nrm(ks[10], (DEPTH, SSM_WIDTH), 1.0),
        'glu_w_val': nrm(ks[11], (DEPTH, SSM_WIDTH, D_MODEL), SSM_WIDTH ** -0.5),
        'glu_w_gate': nrm(ks[12], (DEPTH, SSM_WIDTH, D_MODEL), SSM_WIDTH ** -0.5),
        'q_norm_g': 1.0 + nrm(ks[13], (DEPTH, HEAD_DIM), 0.02),
        'k_norm_g': 1.0 + nrm(ks[14], (DEPTH, HEAD_DIM), 0.02),
        'w_attn_up': nrm(ks[15], (DEPTH, ATTN_OUT, D_MODEL), ATTN_OUT ** -0.5),
        'w_out': nrm(ks[16], (DEPTH, D_MODEL, D_MODEL), D_MODEL ** -0.5),
        'norm_ffn_g': 1.0 + nrm(ks[17], (DEPTH, D_MODEL), 0.02),
        'ffn_w_gate': nrm(ks[18], (DEPTH, D_MODEL, D_FF), D_MODEL ** -0.5),
        'ffn_w_up': nrm(ks[19], (DEPTH, D_MODEL, D_FF), D_MODEL ** -0.5),
        'ffn_conv_w': nrm(ks[20], (DEPTH, CONV_WIDTH, D_FF), CONV_WIDTH ** -0.5),
        'ffn_conv_b': nrm(ks[21], (DEPTH, D_FF), 0.01),
        'ffn_w_down': nrm(ks[22], (DEPTH, D_FF, D_MODEL), D_FF ** -0.5),
    }


def reference(x, norm_mix_g, w_in, ssm_lambda_re, ssm_lambda_im, ssm_log_dt, ssm_b_re, ssm_b_im,
              ssm_c_re, ssm_c_im, ssm_d, glu_w_val, glu_w_gate, q_norm_g, k_norm_g, w_attn_up,
              w_out, norm_ffn_g, ffn_w_gate, ffn_w_up, ffn_conv_w, ffn_conv_b, ffn_w_down):
    b, l, _ = x.shape
    slopes = alibi_slopes()
    scale = HEAD_DIM ** -0.5
    for i in range(DEPTH):
        hmix = rmsnorm(x, norm_mix_g[i])
        proj = hmix @ w_in[i].astype(jnp.float32)
        o1 = SSM_WIDTH
        o2 = o1 + 3 * ATTN_WIDTH
        u_ssm = proj[..., :o1]
        qkv = proj[..., o1:o2].reshape(b, l, 3, N_PATTERNS, HEADS_PER_PATTERN, HEAD_DIM)
        gate_a = jax.nn.sigmoid(proj[..., o2:o2 + D_MODEL])
        gate_b = jax.nn.sigmoid(proj[..., o2 + D_MODEL:])

        y_ssm = jax.nn.gelu(s5_scan(u_ssm, ssm_lambda_re[i], ssm_lambda_im[i], ssm_log_dt[i],
                                    ssm_b_re[i], ssm_b_im[i], ssm_c_re[i], ssm_c_im[i], ssm_d[i]),
                            approximate=False)
        y_a = (y_ssm @ glu_w_val[i].astype(jnp.float32)) * jax.nn.sigmoid(y_ssm @ glu_w_gate[i].astype(jnp.float32))

        q = rmsnorm(qkv[:, :, 0], q_norm_g[i]) * scale
        k = rmsnorm(qkv[:, :, 1], k_norm_g[i])
        v = qkv[:, :, 2]
        outs = []
        lses = []
        for g, (window, dilation) in enumerate(ATTN_PATTERNS):
            o_g, lse_g = dilated_window_attention(q[:, :, g], k[:, :, g], v[:, :, g], slopes[g], window, dilation)
            outs.append(o_g)
            lses.append(lse_g)
        wgt = jax.nn.softmax(jnp.stack(lses, axis=0), axis=0)
        o_attn = jnp.sum(wgt[..., None] * jnp.stack(outs, axis=0), axis=0).reshape(b, l, ATTN_OUT)
        y_b = o_attn @ w_attn_up[i].astype(jnp.float32)

        mixed = (gate_a * y_a + gate_b * y_b) @ w_out[i].astype(jnp.float32)
        x = (x.astype(jnp.float32) + mixed).astype(x.dtype)

        hf = rmsnorm(x, norm_ffn_g[i])
        g_pre = causal_dwconv(hf @ ffn_w_gate[i].astype(jnp.float32), ffn_conv_w[i], ffn_conv_b[i])
        ff = (jax.nn.gelu(g_pre, approximate=False) * (hf @ ffn_w_up[i].astype(jnp.float32))) @ ffn_w_down[i].astype(jnp.float32)
        x = (x.astype(jnp.float32) + ff).astype(x.dtype)
    return x
```

```cpp
#include <hip/hip_runtime.h>
#include <hip/hip_cooperative_groups.h>
#include <cstdio>
#include <cstdint>
namespace cg = cooperative_groups;

#define LAS __attribute__((address_space(3)))
#define PG8_LAS LAS
typedef unsigned short bf16_t;
typedef short bf16x8 __attribute__((ext_vector_type(8)));
typedef short s16x4 __attribute__((ext_vector_type(4)));
typedef float f32x2 __attribute__((ext_vector_type(2)));
typedef float f32x4 __attribute__((ext_vector_type(4)));
typedef float f32x16 __attribute__((ext_vector_type(16)));
typedef unsigned u32x2 __attribute__((ext_vector_type(2)));
typedef unsigned u32x4 __attribute__((ext_vector_type(4)));

constexpr int BATCH = 16, SEQ = 2048, DM = 1024, MTOK = BATCH * SEQ;
constexpr int SSMW = 512, NGRP = 32, NST = 64, GCH = 16;
constexpr int AW = 1536, NHEADS = 24, HD = 64, AOUT = 512;
constexpr int NIN = 7168, DFF = 2816;
constexpr int CT = 32, NCH = SEQ / CT;
constexpr int U2LD = 128 + CT * GCH;
constexpr float EPS = 1e-6f;
constexpr float LOG2E = 1.4426950408889634f;

constexpr size_t MiB = 1u << 20;
constexpr size_t WS_SS = 512 * 1024;
constexpr size_t WS_RINV = 640 * 1024;
constexpr size_t WS_APOW = 768 * 1024;
constexpr size_t WS_WIN = 1 * MiB, WS_WGLU = 15 * MiB, WS_WUP = 17 * MiB, WS_WOUT = 18 * MiB, WS_WGU = 20 * MiB, WS_WDN = 31 * MiB;
constexpr size_t WS_TMAT = 37 * MiB;
constexpr size_t WS_HMAT = 57 * MiB;
constexpr size_t WS_TAIL = 62 * MiB, WS_HEADG = 65 * MiB, WS_HEADU = 68 * MiB;
constexpr size_t WS_GA = 72 * MiB, WS_GB = 136 * MiB;
constexpr size_t WS_Q = 200 * MiB, WS_K = 296 * MiB, WS_V = 392 * MiB;
constexpr size_t WS_END = 488 * MiB;
constexpr size_t WS_YSSM = WS_Q, WS_TMPB = WS_Q + 32 * MiB, WS_MERGED = WS_Q + 96 * MiB, WS_X1B = WS_Q + 176 * MiB, WS_H = WS_Q;
constexpr size_t DO_XN = 0;
constexpr size_t DO_SCR = 0;
constexpr size_t DO_U2 = 80 * MiB;

constexpr int LDS_BYTES = 163840;
constexpr int ZS = 132;
constexpr int LDS_HALO = 139264;
constexpr int LDS_MISC = 143360;
constexpr int VT_BYTES = 32 * 192;

typedef __bf16 bf16x2_t __attribute__((ext_vector_type(2)));
__device__ __forceinline__ unsigned cvt_pk_bf16(float lo, float hi) { const f32x2 v = {lo, hi}; const bf16x2_t b = __builtin_convertvector(v, bf16x2_t); return __builtin_bit_cast(unsigned, b); }
__device__ __forceinline__ float bf_lo(unsigned w) { return __uint_as_float(w << 16); }
__device__ __forceinline__ float bf_hi(unsigned w) { return __uint_as_float(w & 0xffff0000u); }
__device__ __forceinline__ unsigned f2bf(float f) { unsigned u = __float_as_uint(f); return (u + 0x7fffu + ((u >> 16) & 1u)) >> 16; }
__device__ __forceinline__ float sigmoidp_(float x) { return __builtin_amdgcn_rcpf(1.0f + __builtin_amdgcn_exp2f(x)); }
__device__ __forceinline__ unsigned gate4_u8(f32x4 x) { const unsigned a = (unsigned)(sigmoidp_(x[0]) * 255.0f + 0.5f), b = (unsigned)(sigmoidp_(x[1]) * 255.0f + 0.5f), c = (unsigned)(sigmoidp_(x[2]) * 255.0f + 0.5f), d = (unsigned)(sigmoidp_(x[3]) * 255.0f + 0.5f);
    return a | (b << 8) | (c << 16) | (d << 24); }
__device__ __forceinline__ f32x4 gate4_f32(unsigned w) { return (f32x4){(float)(w & 255u), (float)((w >> 8) & 255u), (float)((w >> 16) & 255u), (float)(w >> 24)} * (1.0f / 255.0f); }
__device__ __forceinline__ float wave_sum(float v) {
#pragma unroll
    for (int o = 1; o < 64; o <<= 1) v += __shfl_xor(v, o);
    return v;
}
__device__ __forceinline__ float wave_max(float v) {
#pragma unroll
    for (int o = 1; o < 64; o <<= 1) v = fmaxf(v, __shfl_xor(v, o));
    return v;
}
__device__ __forceinline__ f32x2 gelu_pk(f32x2 v) {
    f32x2 n; n.x = __builtin_fmaxf(-__builtin_fabsf(v.x), -5.6f); n.y = __builtin_fmaxf(-__builtin_fabsf(v.y), -5.6f);
    f32x2 p = n * 3.360643278e-05f + 7.736645178e-04f; p = p * n + 8.095245171e-03f; p = p * n + 5.343466881e-02f; p = p * n + (-4.587538301e-01f); p = p * n + 1.151207531e+00f; p = p * n + (-9.999924068e-01f);
    f32x2 e; e.x = __builtin_amdgcn_exp2f(p.x); e.y = __builtin_amdgcn_exp2f(p.y);
    f32x2 r; r.x = __builtin_fmaxf(v.x, 0.f); r.y = __builtin_fmaxf(v.y, 0.f);
    return __builtin_elementwise_fma(n, e, r);
}
__device__ __forceinline__ f32x4 gelu4(f32x4 v) { const f32x2 a = gelu_pk((f32x2){v[0], v[1]}), b = gelu_pk((f32x2){v[2], v[3]}); return (f32x4){a.x, a.y, b.x, b.y}; }
__device__ __forceinline__ u32x4 pack8(f32x4 a, f32x4 b) { u32x4 w; w.x = cvt_pk_bf16(a[0], a[1]); w.y = cvt_pk_bf16(a[2], a[3]); w.z = cvt_pk_bf16(b[0], b[1]); w.w = cvt_pk_bf16(b[2], b[3]); return w; }
__device__ __forceinline__ void unpack8(u32x4 w, f32x4& a, f32x4& b) { a = (f32x4){bf_lo(w.x), bf_hi(w.x), bf_lo(w.y), bf_hi(w.y)}; b = (f32x4){bf_lo(w.z), bf_hi(w.z), bf_lo(w.w), bf_hi(w.w)}; }

namespace pg8 {
constexpr int BM = 256, BK = 64, HALF = 128, HTB = HALF * BK * 2  , STAGE_BYTES = 8 * HTB, NXCD = 8, WGM = 8;
__host__ __device__ __forceinline__ int lds_byte(int r, int c) { const int st = (r >> 4) * 2 + (c >> 5), rr = r & 15, cc = c & 31, ob = rr * 64 + cc * 2; return st * 1024 + (ob ^ (((ob >> 9) & 1) << 5)); }
__host__ __device__ __forceinline__ void stage_rc(int b, int& R, int& C) { const int st = b / 1024, sb = b % 1024, swz = sb ^ (((sb >> 9) & 1) << 5); R = (st >> 1) * 16 + swz / 64; C = (st & 1) * 32 + (swz % 64) / 2; }
__host__ __device__ __forceinline__ int perm32(int rho) { const int n = rho >> 4, i = rho & 15; return 8 * (i >> 2) + 4 * n + (i & 3); }

struct Unit { int pm, pn, ar, br, amode; };
struct Gemm { const bf16_t* A; const bf16_t* Bt; int K, lda, ldb; int ablk = 0; };

template <int MODE>
struct StaticOrder {
    int nM, nN, nwg, G, c; bool inproj = false;
    __device__ void init(int nM_, int nN_, int G_, int c_) { nM = nM_; nN = nN_; nwg = nM * nN; G = G_; c = c_; }
    __device__ bool next(int i, Unit& u) const {
        const long L = (long)i * G + c; if (L >= nwg) return false;
        int wgid = (int)L; { const int q = nwg / NXCD, r = nwg % NXCD, xcd = wgid % NXCD, off = wgid / NXCD; wgid = (xcd < r ? xcd * (q + 1) : r * (q + 1) + (xcd - r) * q) + off; }
        const int nig = WGM * nN, gid = wgid / nig, fm = gid * WGM, gsz = (nM - fm) < WGM ? (nM - fm) : WGM;
        u.pm = fm + ((wgid % nig) % gsz); u.pn = (wgid % nig) / gsz;
        u.ar = 256 * u.pm; u.amode = 0;
        if (inproj) { const int pn = u.pn;
            if (pn >= 14 && pn < 20) u.amode = 1 + ((pn - 14) >> 1);
            else if (pn >= 2 && pn < 14) { const int dsel = ((pn - 2) % 6) >> 1; u.amode = dsel == 2 ? 4 : (dsel == 1 ? 5 : 0); } }
        u.br = MODE == 0 ? 256 * u.pn : (MODE == 1 ? 128 * (u.pm >> 2) : 512 * (u.pm >> 2) + 256 * u.pn);
        return true;
    }
    __device__ __forceinline__ void a_ready(const Unit&) const {}
    __device__ __forceinline__ void done(const Unit&) const {}
};
template <class Epi, class Sched, bool ALIGN_EPI = false, bool SP2 = false>
__device__ __forceinline__ void gemm_phase(PG8_LAS unsigned char* lds, const Gemm g, const Sched& S, const Epi& E) {
    const int tid = threadIdx.x, wid = __builtin_amdgcn_readfirstlane(tid >> 6), lane = tid & 63, wr = wid >> 2, wc = wid & 3, fr = lane & 15, fq = lane >> 4;
    const int nt = g.K / BK, lda = g.ablk ? BK : g.lda, ldb = g.ldb;
    unsigned voffA[2], voffAn[2], voffB[2];
#pragma unroll
    for (int i = 0; i < 2; ++i) { int R, C; stage_rc(tid * 16 + i * 8192, R, C); const int Rb = Epi::PERM ? ((R & ~31) + perm32(R & 31)) : R;
        const int Ra = Epi::AROW4 ? ((R & 64) + 4 * (R & 15) + ((R >> 4) & 3)) : R;
        voffA[i] = (unsigned)(Ra * lda + C) * 2u; voffB[i] = (unsigned)(Rb * ldb + C) * 2u; }
    const size_t kstep = (size_t)(BK * 2);
    const size_t kstepA = g.ablk ? (size_t)(BM * BK * 2) : kstep, arow = g.ablk ? (size_t)g.K * 2 : (size_t)g.lda * 2;
    size_t hsA = (size_t)HALF * lda * 2, hsAn = hsA; const size_t hsB = (size_t)HALF * ldb * 2;
    auto set_amode = [&](int mode, unsigned* v, size_t& hs) {
        const int lg = mode >= 1 && mode <= 3 ? 2 * (mode - 1) : 0;
        _Pragma("unroll") for (int i = 0; i < 2; ++i) { int R, C; stage_rc(tid * 16 + i * 8192, R, C); int Ra = R;
            const int wr_ = (R >> 6) & 1, m_ = (R >> 4) & 3, fr_ = R & 15, hi_ = fr_ & 1, cs_ = 8 * wr_ + (fr_ >> 1);
            if (mode >= 1 && mode <= 3) Ra = (((16 * (cs_ & ((16 >> lg) - 1)) + 4 * hi_ + m_)) << lg) + (cs_ >> (4 - lg));
            else if (mode == 4) Ra = 16 * fr_ + 4 * wr_ + m_;
            else if (mode == 5) Ra = 64 * wr_ + 4 * fr_ + m_;
            v[i] = (unsigned)(Ra * lda + C) * 2u; }
        hs = (mode >= 1 && mode <= 3) ? (size_t)(8 << lg) * lda * 2 : (mode == 4 ? (size_t)8 * lda * 2 : (size_t)HALF * lda * 2); };
    const unsigned ldsw = (unsigned)wid * 1024u;
    const int aoff = lds_byte(wr * 64 + fr, fq * 8), boff = lds_byte(wc * 32 + fr, fq * 8);
#define PG8_SA(b, h) (((b) * 2 + (h)) * HTB)
#define PG8_SB(b, h) ((4 + (b) * 2 + (h)) * HTB)
#define PG8_STAGE(bufoff, gbase, voff) do { _Pragma("unroll") for (int _i = 0; _i < 2; ++_i) \
        __builtin_amdgcn_global_load_lds((const unsigned*)((const char*)(gbase) + (voff)[_i]), (PG8_LAS unsigned*)(lds + (bufoff) + ldsw + _i * 8192), 16, 0, 0); } while (0)
#define PG8_LDA(dst, b, h) do { _Pragma("unroll") for (int m = 0; m < 4; ++m) _Pragma("unroll") for (int k = 0; k < 2; ++k) dst[m][k] = *(const PG8_LAS bf16x8*)(lds + PG8_SA(b, h) + aoff + m * 2048 + k * 1024); } while (0)
#define PG8_LDB(dst, b, h) do { _Pragma("unroll") for (int n = 0; n < 2; ++n) _Pragma("unroll") for (int k = 0; k < 2; ++k) dst[n][k] = *(const PG8_LAS bf16x8*)(lds + PG8_SB(b, h) + boff + n * 2048 + k * 1024); } while (0)
#define PG8_MMA(ai, bj, At, Bt) do { __builtin_amdgcn_s_setprio(1); _Pragma("unroll") for (int m = 0; m < 4; ++m) _Pragma("unroll") for (int n = 0; n < 2; ++n) _Pragma("unroll") for (int k = 0; k < 2; ++k) \
        acc[ai][bj][m][n] = __builtin_amdgcn_mfma_f32_16x16x32_bf16(Bt[n][k], At[m][k], acc[ai][bj][m][n], 0, 0, 0); __builtin_amdgcn_s_setprio(0); } while (0)
#define PG8_WAIT_V(n) asm volatile("s_waitcnt vmcnt(" #n ")" ::: "memory")
#define PG8_WAIT_V8R do { if (relax_) { if constexpr (Epi::VM_MIN >= 40) { PG8_WAIT_V(48); } else if constexpr (Epi::VM_MIN >= 32) { PG8_WAIT_V(40); } else if constexpr (Epi::VM_MIN >= 24) { PG8_WAIT_V(32); } else if constexpr (Epi::VM_MIN >= 16) { PG8_WAIT_V(24); } else if (relax16_) { PG8_WAIT_V(24); } else { PG8_WAIT_V(16); } } else { PG8_WAIT_V(8); } } while (0)
#define PG8_WAIT_L(n) asm volatile("s_waitcnt lgkmcnt(" #n ")" ::: "memory")
#define PG8_BAR __builtin_amdgcn_s_barrier()
#define PG8_SCHED __builtin_amdgcn_sched_barrier(0)
    Unit cur, nxt; int ui = 0, prv_pn = 0;
    if (!S.next(0, cur)) return;
    if constexpr (Epi::AMODES) { set_amode(cur.amode, voffA, hsA); }
    f32x4 acc[2][2][4][2];
#pragma unroll
    for (int a = 0; a < 2; ++a)
#pragma unroll
        for (int b = 0; b < 2; ++b)
#pragma unroll
            for (int m = 0; m < 4; ++m)
#pragma unroll
                for (int n = 0; n < 2; ++n) acc[a][b][m][n] = (f32x4){0.f, 0.f, 0.f, 0.f};
    bf16x8 At[4][2], B0[2][2], B1[2][2];
    const char* cA = (const char*)g.A + (size_t)cur.ar * arow; const char* cB = (const char*)g.Bt + (size_t)cur.br * ldb * 2;
    S.a_ready(cur);
    if constexpr (SP2) {
        PG8_STAGE(PG8_SB(0, 0), cB, voffB); PG8_STAGE(PG8_SB(0, 1), cB + hsB, voffB); PG8_STAGE(PG8_SA(0, 0), cA, voffA); PG8_STAGE(PG8_SA(0, 1), cA + hsA, voffA);
        if (wr == 1) PG8_BAR;
        PG8_WAIT_V(2); PG8_BAR;
        PG8_STAGE(PG8_SB(1, 0), cB + kstep, voffB); PG8_STAGE(PG8_SA(1, 0), cA + kstepA, voffA); PG8_STAGE(PG8_SB(1, 1), cB + hsB + kstep, voffB);
        PG8_WAIT_V(6); PG8_BAR;
    } else {
        PG8_STAGE(PG8_SB(0, 0), cB, voffB); PG8_STAGE(PG8_SA(0, 0), cA, voffA); PG8_STAGE(PG8_SB(0, 1), cB + hsB, voffB); PG8_STAGE(PG8_SA(0, 1), cA + hsA, voffA);
        if (wr == 1) PG8_BAR;
        PG8_WAIT_V(4); PG8_BAR;
        PG8_STAGE(PG8_SB(1, 0), cB + kstep, voffB); PG8_STAGE(PG8_SA(1, 0), cA + kstepA, voffA); PG8_STAGE(PG8_SB(1, 1), cB + hsB + kstep, voffB);
        PG8_WAIT_V(6); PG8_BAR;
    }
    for (;;) {
        const bool has_next = S.next(ui + 1, nxt);
        if constexpr (Epi::AMODES) { set_amode(has_next ? nxt.amode : cur.amode, voffAn, hsAn); }
        const char* nA = has_next ? (const char*)g.A + (size_t)nxt.ar * arow : cA; const char* nB = has_next ? (const char*)g.Bt + (size_t)nxt.br * ldb * 2 : cB;
        for (int t = 0; t < nt; t += 2) {
            const bool last = (t == nt - 2);
            const char* a1 = cA + (size_t)(t + 1) * kstepA;
            const char* a2 = last ? nA : cA + (size_t)(t + 2) * kstepA; const char* b2 = last ? nB : cB + (size_t)(t + 2) * kstep;
            const char* a3 = a2 + kstepA; const char* b3 = b2 + kstep;
            if (last && has_next) S.a_ready(nxt);
            unsigned vA2_[2]; size_t hsA2;
            if constexpr (Epi::AMODES) { vA2_[0] = last ? voffAn[0] : voffA[0]; vA2_[1] = last ? voffAn[1] : voffA[1]; hsA2 = last ? hsAn : hsA; } else { vA2_[0] = voffA[0]; vA2_[1] = voffA[1]; hsA2 = hsA; }
            const bool relax_ = __builtin_amdgcn_readfirstlane((int)(Epi::VM_MIN >= 8 && t == 0 && ui > 0)) != 0;
            const bool relax16_ = __builtin_amdgcn_readfirstlane((int)(Epi::AMODES && t == 0 && ui > 0 && prv_pn < 20)) != 0;
            if constexpr (SP2) {
            PG8_LDB(B0, 0, 0); PG8_LDB(B1, 0, 1); PG8_SCHED; PG8_LDA(At, 0, 0); PG8_STAGE(PG8_SA(1, 1), a1 + hsA, voffA);
            PG8_WAIT_V8R; PG8_WAIT_L(0); PG8_BAR; PG8_MMA(0, 0, At, B0); PG8_MMA(0, 1, At, B1); PG8_BAR; PG8_SCHED;
            PG8_LDA(At, 0, 1); PG8_STAGE(PG8_SB(0, 0), b2, voffB); PG8_STAGE(PG8_SB(0, 1), b2 + hsB, voffB); PG8_STAGE(PG8_SA(0, 0), a2, vA2_);
            PG8_WAIT_V8R; PG8_WAIT_L(0); PG8_BAR; PG8_MMA(1, 0, At, B0); PG8_MMA(1, 1, At, B1); PG8_BAR; PG8_SCHED;
            PG8_LDB(B0, 1, 0); PG8_LDB(B1, 1, 1); PG8_SCHED; PG8_LDA(At, 1, 0); PG8_STAGE(PG8_SA(0, 1), a2 + hsA2, vA2_);
            PG8_WAIT_V(8); PG8_WAIT_L(0); PG8_BAR; PG8_MMA(0, 0, At, B0); PG8_MMA(0, 1, At, B1); PG8_BAR; PG8_SCHED;
            PG8_LDA(At, 1, 1); PG8_STAGE(PG8_SB(1, 0), b3, voffB); PG8_STAGE(PG8_SB(1, 1), b3 + hsB, voffB); PG8_STAGE(PG8_SA(1, 0), a3, vA2_);
            PG8_WAIT_V(8); PG8_WAIT_L(0); PG8_BAR; PG8_MMA(1, 0, At, B0); PG8_MMA(1, 1, At, B1); PG8_BAR; PG8_SCHED;
            } else {
            PG8_LDB(B0, 0, 0); PG8_SCHED; PG8_LDA(At, 0, 0); PG8_STAGE(PG8_SA(1, 1), a1 + hsA, voffA);
            PG8_WAIT_L(8); PG8_BAR; PG8_WAIT_L(0); PG8_MMA(0, 0, At, B0); PG8_BAR; PG8_SCHED;
            PG8_LDB(B1, 0, 1); PG8_STAGE(PG8_SB(0, 0), b2, voffB);
            PG8_BAR; PG8_WAIT_L(0); PG8_MMA(0, 1, At, B1); PG8_BAR;
            PG8_LDA(At, 0, 1); PG8_STAGE(PG8_SA(0, 0), a2, vA2_);
            PG8_BAR; PG8_WAIT_L(0); PG8_MMA(1, 0, At, B0); PG8_BAR; PG8_SCHED;
            PG8_STAGE(PG8_SB(0, 1), b2 + hsB, voffB);
            PG8_WAIT_V(6); PG8_BAR; PG8_MMA(1, 1, At, B1); PG8_BAR;
            PG8_LDB(B0, 1, 0); PG8_SCHED; PG8_LDA(At, 1, 0); PG8_STAGE(PG8_SA(0, 1), a2 + hsA2, vA2_);
            PG8_WAIT_L(8); PG8_BAR; PG8_WAIT_L(0); PG8_MMA(0, 0, At, B0); PG8_BAR; PG8_SCHED;
            PG8_LDB(B1, 1, 1); PG8_STAGE(PG8_SB(1, 0), b3, voffB);
            PG8_BAR; PG8_WAIT_L(0); PG8_MMA(0, 1, At, B1); PG8_BAR;
            PG8_LDA(At, 1, 1); PG8_STAGE(PG8_SA(1, 0), a3, vA2_);
            PG8_BAR; PG8_WAIT_L(0); PG8_MMA(1, 0, At, B0); PG8_BAR; PG8_SCHED;
            PG8_STAGE(PG8_SB(1, 1), b3 + hsB, voffB);
            PG8_WAIT_V(6); PG8_BAR; PG8_MMA(1, 1, At, B1); PG8_BAR;
            }
        }
        if constexpr (ALIGN_EPI) { if (wr == 0) PG8_BAR; }
        if constexpr (!Epi::AFTER_DRAIN) { E(acc, cur, wr, wc, fr, fq); S.done(cur); }
        if (!has_next) break;
#pragma unroll
        for (int a = 0; a < 2; ++a)
#pragma unroll
            for (int b = 0; b < 2; ++b)
#pragma unroll
                for (int m = 0; m < 4; ++m)
#pragma unroll
                    for (int n = 0; n < 2; ++n) acc[a][b][m][n] = (f32x4){0.f, 0.f, 0.f, 0.f};
        prv_pn = cur.pn; cur = nxt; cA = nA; cB = nB; ++ui;
        if constexpr (Epi::AMODES) { voffA[0] = voffAn[0]; voffA[1] = voffAn[1]; hsA = hsAn; }
        if constexpr (ALIGN_EPI) { if (wr == 1) PG8_BAR; }
    }
    PG8_WAIT_V(0);
    if constexpr (!ALIGN_EPI) { if (wr == 0) PG8_BAR; }
    PG8_BAR;
    if constexpr (Epi::AFTER_DRAIN) { E.fused(acc, cur, wr, wc, fr, fq, lds, wid, lane); S.done(cur); }
#undef PG8_SA
#undef PG8_SB
#undef PG8_STAGE
#undef PG8_LDA
#undef PG8_LDB
#undef PG8_MMA
#undef PG8_WAIT_V
#undef PG8_WAIT_V8R
#undef PG8_WAIT_L
#undef PG8_BAR
#undef PG8_SCHED
}}

using pg8::Unit;
typedef f32x4 Acc[2][2][4][2];

#ifndef ST_AUX
#define ST_AUX 18
#endif
template <int W> __device__ __forceinline__ size_t blk_idx(int row, int c) { return ((size_t)((row >> 8) * (W / 64) + (c >> 6)) * 256 + (row & 255)) * 64 + (c & 63); }

__device__ __forceinline__ void st16b(bf16_t* base, bf16_t* p, u32x4 v) {
    const __amdgpu_buffer_rsrc_t r = __builtin_amdgcn_make_buffer_rsrc((void*)base, (short)0, 0x7fffffff, 0x00020000);
    __builtin_amdgcn_raw_buffer_store_b128(v, r, (int)((char*)p - (char*)base), 0, ST_AUX);
}
struct EpiInProj {
    static constexpr bool PERM = true, AFTER_DRAIN = false; static constexpr int VM_MIN = 8;
    static constexpr bool AROW4 = false, AMODES = true;
    bf16_t *U2, *Q, *K, *V, *GA, *GB; const float *qg, *kg;
    __device__ __forceinline__ void operator()(Acc& acc, const Unit& u, int wr, int wc, int fr, int fq) const {
        const int pn = u.pn, row0 = u.pm * 256 + wr * 64 + fr;
        if (pn < 2) {
#pragma unroll
            for (int ai = 0; ai < 2; ++ai)
#pragma unroll
                for (int m = 0; m < 4; ++m) { const int row = row0 + ai * 128 + m * 16, b = row >> 11, t = row & 2047, c = t >> 5, i = t & 31;
#pragma unroll
                    for (int bj = 0; bj < 2; ++bj) { const int cl = 256 * pn + 128 * bj + 32 * wc + 8 * fq, g = cl >> 4;
                        bf16_t* dst = U2 + ((size_t)(g * 1024 + b * 64 + c) * U2LD + 128 + i * 16 + (cl & 15));
                        *(u32x4*)dst = pack8(acc[ai][bj][m][0], acc[ai][bj][m][1]);     } }
        } else if (pn < 14) {
            const bool isq = pn < 8; const int head = 4 * (isq ? pn - 2 : pn - 8) + wc, lg = 2 * (head >> 3);
            const float* gs = isq ? qg : kg; bf16_t* base = (isq ? Q : K) + 8 * (32 * (fq & 1)) + 512 * (fq >> 1);
            const float sc = isq ? 0.125f * LOG2E : 1.0f;
            f32x4 gv[2][2];
#pragma unroll
            for (int bj = 0; bj < 2; ++bj)
#pragma unroll
                for (int n = 0; n < 2; ++n) gv[bj][n] = *(const f32x4*)(gs + 32 * bj + 8 * fq + 4 * n) * sc;
#pragma unroll
            for (int ai = 0; ai < 2; ++ai)
#pragma unroll
                for (int m = 0; m < 4; ++m) { float ss = 0.f;
#pragma unroll
                    for (int bj = 0; bj < 2; ++bj)
#pragma unroll
                        for (int n = 0; n < 2; ++n) { const f32x4 x = acc[ai][bj][m][n]; ss += (x[0] * x[0] + x[1] * x[1]) + (x[2] * x[2] + x[3] * x[3]); }
                    ss += __shfl_xor(ss, 16); ss += __shfl_xor(ss, 32);
                    const float rs = __builtin_amdgcn_rsqf(ss * (1.0f / 64.0f) + EPS);
                    const int trow = lg == 0 ? wr * 64 + fr + ai * 128 + m * 16 : (lg == 2 ? 128 * ai + 64 * wr + 4 * fr + m : 16 * fr + 8 * ai + 4 * wr + m);
                    const int row = u.pm * 256 + trow, b = row >> 11, t = row & 2047, tp = ((t & ((1 << lg) - 1)) << (11 - lg)) + (t >> lg);
                    bf16_t* rowp = base + ((size_t)(b * NHEADS + head) * SEQ + (tp & ~31)) * HD + 8 * (tp & 31);
#pragma unroll
                    for (int bj = 0; bj < 2; ++bj) st16b(isq ? Q : K, rowp + 1024 * bj, pack8(acc[ai][bj][m][0] * rs * gv[bj][0], acc[ai][bj][m][1] * rs * gv[bj][1])); }
        } else if (pn < 20) {
            const int lg = 2 * ((pn - 14) >> 1), hi_ = fr & 1, cs = 8 * wr + (fr >> 1), c = cs >> (4 - lg), sg = cs & ((16 >> lg) - 1);
            const int tile_t0 = (u.pm * 256) & 2047, b = (u.pm * 256) >> 11;
            const int rb16 = c * (2048 >> lg) + (tile_t0 >> lg) + 16 * sg;
            const size_t blk = (size_t)(rb16 & ~31) * HD + (size_t)(2 * (wc & 1) + ((rb16 >> 4) & 1)) * 512 + hi_ * 256 + fq * 8;
#pragma unroll
            for (int bj = 0; bj < 2; ++bj) { const int head = 4 * (pn - 14) + 2 * bj + (wc >> 1); bf16_t* hp = V + (size_t)(b * NHEADS + head) * SEQ * HD + blk;
#pragma unroll
                for (int n = 0; n < 2; ++n)
#pragma unroll
                    for (int e = 0; e < 4; ++e) { u32x4 w;
                        w.x = cvt_pk_bf16(acc[0][bj][0][n][e], acc[0][bj][1][n][e]); w.y = cvt_pk_bf16(acc[0][bj][2][n][e], acc[0][bj][3][n][e]);
                        w.z = cvt_pk_bf16(acc[1][bj][0][n][e], acc[1][bj][1][n][e]); w.w = cvt_pk_bf16(acc[1][bj][2][n][e], acc[1][bj][3][n][e]);
                        st16b(V, hp + (4 * n + e) * 32, w); } }
        } else {
            int fq_ = fq; asm volatile("" : "+v"(fq_));
            unsigned char* base = (unsigned char*)(pn < 24 ? GA : GB) + 256 * (pn < 24 ? pn - 20 : pn - 24) + 64 * wc + 16 * fq_;
#pragma unroll
            for (int ai = 0; ai < 2; ++ai)
#pragma unroll
                for (int m = 0; m < 4; ++m) { unsigned char* rowp = base + (size_t)(row0 + ai * 128 + m * 16) * DM; u32x4 w;
                    w.x = gate4_u8(acc[ai][0][m][0]); w.y = gate4_u8(acc[ai][0][m][1]); w.z = gate4_u8(acc[ai][1][m][0]); w.w = gate4_u8(acc[ai][1][m][1]);
                    st16b(pn < 24 ? GA : GB, (bf16_t*)rowp, w); __builtin_amdgcn_sched_barrier(0); }
        }
    }
};

struct EpiSsmState {
    static constexpr bool PERM = false, AFTER_DRAIN = true; static constexpr int VM_MIN = 0; static constexpr bool AROW4 = false, AMODES = false;
    bf16_t* U2; const f32x2* APOW;
    __device__ __forceinline__ void fused(Acc& acc, const Unit& u, int wr, int wc, int fr, int fq, LAS unsigned char* lds, int wid, int lane) const {
        LAS float* Z = (LAS float*)lds;
#pragma unroll
        for (int ai = 0; ai < 2; ++ai)
#pragma unroll
            for (int m = 0; m < 4; ++m)
#pragma unroll
                for (int n = 0; n < 2; ++n) *(LAS f32x4*)(Z + (ai * 128 + wr * 64 + m * 16 + fr) * ZS + 32 * wc + 16 * n + 4 * fq) = acc[ai][0][m][n];
        asm volatile("s_waitcnt lgkmcnt(0)" ::: "memory"); __builtin_amdgcn_s_barrier(); asm volatile("" ::: "memory");
        const int tid = wid * 64 + lane;
        if (tid < 256) {
            const int bl = tid >> 6, p = tid & 63, g = u.pm >> 2;
            const f32x2 a = APOW[g * 64 + p]; float sr = 0.f, si = 0.f;
            bf16_t* dst = U2 + (size_t)(u.pm * 256 + bl * 64) * U2LD + p; const LAS float* zp = Z + (bl * 64) * ZS + p;
            float zr[NCH], zi[NCH];
#pragma unroll
            for (int c = 0; c < NCH; ++c) { zr[c] = zp[c * ZS]; zi[c] = zp[c * ZS + 64]; }
#pragma unroll
            for (int c = 0; c < NCH; ++c) {
                dst[(size_t)c * U2LD] = (bf16_t)f2bf(sr); dst[(size_t)c * U2LD + 64] = (bf16_t)f2bf(si);
                const float nr = a.x * sr - a.y * si + zr[c], ni = a.x * si + a.y * sr + zi[c]; sr = nr; si = ni;
            }
        }
        asm volatile("s_waitcnt lgkmcnt(0)" ::: "memory"); __builtin_amdgcn_s_barrier(); asm volatile("" ::: "memory");
    }
};

struct EpiSsmOut {
    static constexpr bool PERM = true, AFTER_DRAIN = false; static constexpr int VM_MIN = 16; static constexpr bool AROW4 = false, AMODES = false;
    bf16_t* Y;
    __device__ __forceinline__ void operator()(Acc& acc, const Unit& u, int wr, int wc, int fr, int fq) const {
        const int g = u.pm >> 2;
#pragma unroll
        for (int ai = 0; ai < 2; ++ai) {
#pragma unroll
            for (int bj = 0; bj < 2; ++bj) { const int n0 = 256 * u.pn + 128 * bj + 32 * wc + 8 * fq, i = n0 >> 4, co0 = n0 & 15;
#pragma unroll
                for (int m = 0; m < 4; ++m) { const int rl = 256 * (u.pm & 3) + 128 * ai + 64 * wr + 16 * m + fr, b = rl >> 6, c = rl & 63;
                    const f32x4 y0 = gelu4(acc[ai][bj][m][0]), y1 = gelu4(acc[ai][bj][m][1]);
                    *(u32x4*)(Y + blk_idx<SSMW>(b * SEQ + c * CT + i, g * 16 + co0)) = pack8(y0, y1); } } }
    }
};

struct EpiUp {
    static constexpr bool PERM = true, AFTER_DRAIN = false; static constexpr int VM_MIN = 24; static constexpr bool AROW4 = false, AMODES = false;
    const bf16_t* GB; bf16_t* T;
    __device__ __forceinline__ void operator()(Acc& acc, const Unit& u, int wr, int wc, int fr, int fq) const {
        const size_t off0 = (size_t)(u.pm * 256 + wr * 64 + fr) * DM + 256 * u.pn + 32 * wc + 8 * fq;
        const unsigned char* gbase = (const unsigned char*)GB + (size_t)(u.pm * 256 + wr * 64 + fr) * DM + 256 * u.pn + 64 * wc + 16 * fq;
#pragma unroll
        for (int ai = 0; ai < 2; ++ai) { u32x4 gq[4];
#pragma unroll
            for (int m = 0; m < 4; ++m) gq[m] = *(const u32x4*)(gbase + (size_t)(ai * 128 + m * 16) * DM);
            __builtin_amdgcn_sched_barrier(0);
#pragma unroll
            for (int m = 0; m < 4; ++m)
#pragma unroll
                for (int bj = 0; bj < 2; ++bj) { const f32x4 ga = gate4_f32(bj == 0 ? gq[m].x : gq[m].z), gb = gate4_f32(bj == 0 ? gq[m].y : gq[m].w);
                    *(u32x4*)(T + off0 + (size_t)(ai * 128 + m * 16) * DM + 128 * bj) = pack8(acc[ai][bj][m][0] * ga, acc[ai][bj][m][1] * gb); } }
    }
};

struct EpiGlu {
    static constexpr bool PERM = true, AFTER_DRAIN = false; static constexpr int VM_MIN = 24; static constexpr bool AROW4 = false, AMODES = false;
    const bf16_t *GA, *T; bf16_t* MG;
    __device__ __forceinline__ void operator()(Acc& acc, const Unit& u, int wr, int wc, int fr, int fq) const {
        const size_t off0 = (size_t)(u.pm * 256 + wr * 64 + fr) * DM + 128 * u.pn + 32 * wc + 8 * fq;
        const unsigned char* gbase = (const unsigned char*)GA + (size_t)(u.pm * 256 + wr * 64 + fr) * DM + 256 * (u.pn >> 1) + 64 * wc + 16 * fq + 8 * (u.pn & 1);
#pragma unroll
        for (int ai = 0; ai < 2; ++ai) { u32x2 gq[4]; u32x4 tq[4];
#pragma unroll
            for (int m = 0; m < 4; ++m) { gq[m] = *(const u32x2*)(gbase + (size_t)(ai * 128 + m * 16) * DM); tq[m] = *(const u32x4*)(T + off0 + (size_t)(ai * 128 + m * 16) * DM); }
            __builtin_amdgcn_sched_barrier(0);
#pragma unroll
            for (int m = 0; m < 4; ++m) { f32x4 ta, tb; unpack8(tq[m], ta, tb); const f32x4 ga = gate4_f32(gq[m].x), gb = gate4_f32(gq[m].y);
                f32x4 va = acc[ai][0][m][0], vb = acc[ai][0][m][1]; const f32x4 sa = acc[ai][1][m][0], sb = acc[ai][1][m][1];
#pragma unroll
                for (int e = 0; e < 4; ++e) { va[e] = ga[e] * va[e] * sigmoidp_(sa[e]) + ta[e]; vb[e] = gb[e] * vb[e] * sigmoidp_(sb[e]) + tb[e]; }
                *(u32x4*)(MG + blk_idx<DM>(u.pm * 256 + wr * 64 + fr + ai * 128 + m * 16, 128 * u.pn + 32 * wc + 8 * fq)) = pack8(va, vb); } }
    }
};

struct EpiOut {
    static constexpr bool PERM = true, AFTER_DRAIN = false; static constexpr int VM_MIN = 40; static constexpr bool AROW4 = false, AMODES = false;
    const bf16_t* XN; const float* RINV; bf16_t* X1B; float* SS;
    __device__ __forceinline__ void operator()(Acc& acc, const Unit& u, int wr, int wc, int fr, int fq) const {
        const size_t off0 = (size_t)(u.pm * 256 + wr * 64 + fr) * DM + 256 * u.pn + 32 * wc + 8 * fq;
#pragma unroll
        for (int ai = 0; ai < 2; ++ai) { u32x4 xq[4][2]; float ri[4];
#pragma unroll
            for (int m = 0; m < 4; ++m) { ri[m] = RINV[u.pm * 256 + ai * 128 + wr * 64 + m * 16 + fr];
#pragma unroll
                for (int bj = 0; bj < 2; ++bj) xq[m][bj] = *(const u32x4*)(XN + off0 + (size_t)(ai * 128 + m * 16) * DM + 128 * bj); }
            __builtin_amdgcn_sched_barrier(0);
#pragma unroll
            for (int m = 0; m < 4; ++m) { const int row = u.pm * 256 + ai * 128 + wr * 64 + m * 16 + fr; const size_t off = off0 + (size_t)(ai * 128 + m * 16) * DM; float ss = 0.f;
#pragma unroll
                for (int bj = 0; bj < 2; ++bj) { f32x4 xa, xb; unpack8(xq[m][bj], xa, xb); const f32x4 a = acc[ai][bj][m][0] + xa * ri[m], b = acc[ai][bj][m][1] + xb * ri[m];
                    *(u32x4*)(X1B + off + 128 * bj) = pack8(a, b);
                    ss += (a[0] * a[0] + a[1] * a[1]) + (a[2] * a[2] + a[3] * a[3]) + (b[0] * b[0] + b[1] * b[1]) + (b[2] * b[2] + b[3] * b[3]); }
                ss += __shfl_xor(ss, 16); ss += __shfl_xor(ss, 32);
                if (fq == 0) atomicAdd(SS + row, ss); } }
    }
};

__device__ __forceinline__ float dpp_shr1(float old, float src) { return __int_as_float(__builtin_amdgcn_update_dpp(__float_as_int(old), __float_as_int(src), 0x111, 0xF, 0xF, false)); }
__device__ __forceinline__ float dpp_shr2(float old, float src) { return __int_as_float(__builtin_amdgcn_update_dpp(__float_as_int(old), __float_as_int(src), 0x112, 0xF, 0xF, false)); }

__device__ __forceinline__ size_t h_idx(int row, int f) { return ((size_t)((row >> 8) * (DFF / 64) + (f >> 6)) * 256 + (row & 255)) * 64 + (f & 63); }

struct EpiFfn {
    static constexpr bool PERM = true, AFTER_DRAIN = false; static constexpr int VM_MIN = 16; static constexpr bool AROW4 = true, AMODES = false;
    const float *SS, *cw, *cb; bf16_t* H; float *TAIL, *HEADG, *HEADU; LAS float* halo;
    __device__ __forceinline__ void operator()(Acc& acc, const Unit& u, int wr, int wc, int fr, int fq) const {
        const int f0 = 128 * u.pn + 32 * wc + 8 * fq, rowb = u.pm * 256 + wr * 64 + 4 * fr;
        f32x4 w0[2], w1[2], w2[2], bv[2];
#pragma unroll
        for (int n = 0; n < 2; ++n) { w0[n] = *(const f32x4*)(cw + f0 + 4 * n); w1[n] = *(const f32x4*)(cw + DFF + f0 + 4 * n); w2[n] = *(const f32x4*)(cw + 2 * DFF + f0 + 4 * n); bv[n] = *(const f32x4*)(cb + f0 + 4 * n); }
#pragma unroll
        for (int ai = 0; ai < 2; ++ai) { const f32x4 ssv = *(const f32x4*)(SS + rowb + ai * 128);
#pragma unroll
            for (int m = 0; m < 4; ++m) { const float rs = __builtin_amdgcn_rsqf(ssv[m] * (1.0f / DM) + EPS);
#pragma unroll
                for (int bj = 0; bj < 2; ++bj)
#pragma unroll
                    for (int n = 0; n < 2; ++n) acc[ai][bj][m][n] *= rs; } }
        if (fr == 15) {
#pragma unroll
            for (int ai = 0; ai < 2; ++ai)
#pragma unroll
                for (int ms = 0; ms < 2; ++ms)
#pragma unroll
                    for (int n = 0; n < 2; ++n) *(LAS f32x4*)(halo + ((((2 * ai + wr) * 4 + wc) * 2 + ms) * 4 + fq) * 8 + 4 * n) = acc[ai][0][2 + ms][n];
            if (wr == 1) {
#pragma unroll
                for (int ms = 0; ms < 2; ++ms)
#pragma unroll
                    for (int n = 0; n < 2; ++n) *(f32x4*)(TAIL + ((size_t)u.pm * 2 + ms) * DFF + f0 + 4 * n) = acc[1][0][2 + ms][n]; }
        }
        if (fr == 0 && wr == 0) {
#pragma unroll
            for (int ms = 0; ms < 2; ++ms)
#pragma unroll
                for (int n = 0; n < 2; ++n) { *(f32x4*)(HEADG + ((size_t)u.pm * 2 + ms) * DFF + f0 + 4 * n) = acc[0][0][ms][n]; *(f32x4*)(HEADU + ((size_t)u.pm * 2 + ms) * DFF + f0 + 4 * n) = acc[0][1][ms][n]; } }
        asm volatile("s_waitcnt lgkmcnt(0)" ::: "memory"); __builtin_amdgcn_s_barrier(); asm volatile("" ::: "memory");
#pragma unroll
        for (int ai = 0; ai < 2; ++ai) { const int idx = 2 * ai + wr;
            f32x4 tm1[2], tm2[2];
#pragma unroll
            for (int n = 0; n < 2; ++n) { f32x4 h1, h2;
                if (idx > 0) { h1 = *(const LAS f32x4*)(halo + ((((idx - 1) * 4 + wc) * 2 + 1) * 4 + fq) * 8 + 4 * n); h2 = *(const LAS f32x4*)(halo + ((((idx - 1) * 4 + wc) * 2 + 0) * 4 + fq) * 8 + 4 * n); }
                else { h1 = (f32x4){0.f, 0.f, 0.f, 0.f}; h2 = h1; }
#pragma unroll
                for (int e = 0; e < 4; ++e) { tm1[n][e] = dpp_shr1(h1[e], acc[ai][0][3][n][e]); tm2[n][e] = dpp_shr1(h2[e], acc[ai][0][2][n][e]); } }
#pragma unroll
            for (int m = 0; m < 4; ++m) { f32x4 hv[2];
#pragma unroll
                for (int n = 0; n < 2; ++n) { const f32x4 cur = acc[ai][0][m][n];
                    const f32x4 p1 = m == 0 ? tm1[n] : acc[ai][0][m - 1][n], p2 = m == 0 ? tm2[n] : (m == 1 ? tm1[n] : acc[ai][0][m - 2][n]);
                    const f32x4 gp = w2[n] * cur + w1[n] * p1 + w0[n] * p2 + bv[n];
                    hv[n] = gelu4(gp) * acc[ai][1][m][n]; }
                st16b(H, H + h_idx(rowb, f0) + (ai * 128 + m) * 64, pack8(hv[0], hv[1])); } }
    }
};

struct EpiDown {
    static constexpr bool PERM = true, AFTER_DRAIN = false; static constexpr int VM_MIN = 40; static constexpr bool AROW4 = false, AMODES = false;
    const bf16_t* X1B; float* OUT;
    __device__ __forceinline__ void operator()(Acc& acc, const Unit& u, int wr, int wc, int fr, int fq) const {
        const size_t off0 = (size_t)(u.pm * 256 + wr * 64 + fr) * DM + 256 * u.pn + 32 * wc + 8 * fq;
#pragma unroll
        for (int ai = 0; ai < 2; ++ai) { u32x4 xq[4][2];
#pragma unroll
            for (int m = 0; m < 4; ++m)
#pragma unroll
                for (int bj = 0; bj < 2; ++bj) xq[m][bj] = *(const u32x4*)(X1B + off0 + (size_t)(ai * 128 + m * 16) * DM + 128 * bj);
            __builtin_amdgcn_sched_barrier(0);
#pragma unroll
            for (int m = 0; m < 4; ++m)
#pragma unroll
                for (int bj = 0; bj < 2; ++bj) { float* p = OUT + off0 + (size_t)(ai * 128 + m * 16) * DM + 128 * bj; f32x4 xa, xb; unpack8(xq[m][bj], xa, xb);
                    *(f32x4*)p = acc[ai][bj][m][0] + xa; *(f32x4*)(p + 4) = acc[ai][bj][m][1] + xb; } }
    }
};

__device__ __forceinline__ void p0_transpose_item(const float* W0, const float* W1, int ldw, int K, int Nphys, bf16_t* WT, const float* kscale, int mode, LAS float* scr, int item, int lane, float gmul = 1.0f) {
    const int nblk = Nphys / 32, kb = item / nblk, nb = item % nblk, k0 = 64 * kb, n0 = 32 * nb;
    const float* W = W0; int c0 = n0;
    float cm = 1.0f;
    if (mode == 1) { const int pn = n0 >> 8, p = n0 & 255; if (pn >= 2 && pn < 14) c0 = 256 * pn + 64 * ((p >> 5) & 3) + 32 * (p >> 7); if (pn >= 20) cm = gmul; }
    else if (mode == 2) { const int pn = n0 >> 8, p = n0 & 255; W = (p < 128) ? W0 : W1; c0 = 128 * pn + (p & 127); if (p >= 128) cm = gmul; }
    float wv[32];
#pragma unroll
    for (int i = 0; i < 32; ++i) wv[i] = W[(size_t)(k0 + 2 * i + (lane >> 5)) * ldw + c0 + (lane & 31)];
    if (kscale) {
#pragma unroll
        for (int i = 0; i < 32; ++i) wv[i] *= kscale[k0 + 2 * i + (lane >> 5)]; }
#pragma unroll
    for (int i = 0; i < 32; ++i) wv[i] *= cm;
#pragma unroll
    for (int i = 0; i < 32; ++i) scr[(2 * i + (lane >> 5)) * 33 + (lane & 31)] = wv[i];
    asm volatile("s_waitcnt lgkmcnt(0)" ::: "memory");
    const int c = lane & 7;
#pragma unroll
    for (int j = 0; j < 4; ++j) { const int n = (lane >> 3) + 8 * j; const LAS float* s = scr + (8 * c) * 33 + n;
        u32x4 o; o.x = cvt_pk_bf16(s[0 * 33], s[1 * 33]); o.y = cvt_pk_bf16(s[2 * 33], s[3 * 33]); o.z = cvt_pk_bf16(s[4 * 33], s[5 * 33]); o.w = cvt_pk_bf16(s[6 * 33], s[7 * 33]);
        *(u32x4*)(WT + (size_t)(n0 + n) * K + k0 + 8 * c) = o; }
    asm volatile("s_waitcnt lgkmcnt(0)" ::: "memory");
}

__device__ __forceinline__ double d_exp(double x) {
    const double n = __builtin_rint(x * 1.4426950408889634), r = __builtin_fma(-n, 1.9082149292705877e-10, __builtin_fma(-n, 0.6931471803691238, x));
    double p = 1.0 / 6227020800.0;
    p = __builtin_fma(p, r, 1.0 / 479001600.0); p = __builtin_fma(p, r, 1.0 / 39916800.0); p = __builtin_fma(p, r, 1.0 / 3628800.0); p = __builtin_fma(p, r, 1.0 / 362880.0);
    p = __builtin_fma(p, r, 1.0 / 40320.0); p = __builtin_fma(p, r, 1.0 / 5040.0); p = __builtin_fma(p, r, 1.0 / 720.0); p = __builtin_fma(p, r, 1.0 / 120.0);
    p = __builtin_fma(p, r, 1.0 / 24.0); p = __builtin_fma(p, r, 1.0 / 6.0); p = __builtin_fma(p, r, 0.5); p = __builtin_fma(p, r, 1.0); p = __builtin_fma(p, r, 1.0);
    const long long e = (long long)n + 1023; const double sc = __builtin_bit_cast(double, (unsigned long long)e << 52);
    return p * sc;
}
__device__ __forceinline__ void d_sincos(double x, double& s, double& c) {
    const double k = __builtin_rint(x * 0.6366197723675814); double r = __builtin_fma(-k, 1.5707963267948966, x); r = __builtin_fma(-k, 6.123233995736766e-17, r);
    const double r2 = r * r;
    double ps = -1.0 / 1307674368000.0; ps = __builtin_fma(ps, r2, 1.0 / 6227020800.0); ps = __builtin_fma(ps, r2, -1.0 / 39916800.0); ps = __builtin_fma(ps, r2, 1.0 / 362880.0);
    ps = __builtin_fma(ps, r2, -1.0 / 5040.0); ps = __builtin_fma(ps, r2, 1.0 / 120.0); ps = __builtin_fma(ps, r2, -1.0 / 6.0); ps = __builtin_fma(ps * r2, r, r);
    double pc = 1.0 / 20922789888000.0; pc = __builtin_fma(pc, r2, -1.0 / 87178291200.0); pc = __builtin_fma(pc, r2, 1.0 / 479001600.0); pc = __builtin_fma(pc, r2, -1.0 / 3628800.0);
    pc = __builtin_fma(pc, r2, 1.0 / 40320.0); pc = __builtin_fma(pc, r2, -1.0 / 720.0); pc = __builtin_fma(pc, r2, 1.0 / 24.0); pc = __builtin_fma(pc, r2, -0.5); pc = __builtin_fma(pc, r2, 1.0);
    const int q = (int)((long long)k & 3);
    s = (q == 0) ? ps : (q == 1) ? pc : (q == 2) ? -ps : -pc;
    c = (q == 0) ? pc : (q == 1) ? -ps : (q == 2) ? -pc : ps;
}
__device__ __forceinline__ void ssm_pow(const float* lam_re, const float* lam_im, const float* log_dt, int g, int p, int tau, bool times_coef, float& ore, float& oim) {
    const double dt = d_exp((double)log_dt[g]), lr = (double)lam_re[g * 64 + p], li = (double)lam_im[g * 64 + p];
    double s, c; d_sincos(li * dt * tau, s, c); const double mag = d_exp(lr * dt * tau); double wr = mag * c, wi = mag * s;
    if (times_coef) { double s1, c1; d_sincos(li * dt, s1, c1); const double m1 = d_exp(lr * dt), ar = m1 * c1, ai = m1 * s1, den = lr * lr + li * li;
        const double cr = ((ar - 1.0) * lr + ai * li) / den, ci = (ai * lr - (ar - 1.0) * li) / den; const double tr = wr * cr - wi * ci, ti = wr * ci + wi * cr; wr = tr; wi = ti; }
    ore = (float)wr; oim = (float)wi;
}
__device__ __forceinline__ void p0_toeplitz(const float* lam_re, const float* lam_im, const float* log_dt, const float* b_re, const float* b_im, const float* c_re, const float* c_im, const float* Dskip, bf16_t* TM, int g, int tau, int lane) {
    float wre, wim; ssm_pow(lam_re, lam_im, log_dt, g, lane, tau, true, wre, wim);
    const int co = lane >> 2, cq = lane & 3; float o0 = 0.f, o1 = 0.f, o2 = 0.f, o3 = 0.f;
    for (int p = 0; p < 64; ++p) { const float wr = __shfl(wre, p), wi = __shfl(wim, p);
        const float cr = c_re[(g * 16 + co) * 64 + p], ci = c_im[(g * 16 + co) * 64 + p]; const float xr = cr * wr - ci * wi, xi = cr * wi + ci * wr;
        const f32x4 br = *(const f32x4*)(b_re + (g * 64 + p) * 16 + 4 * cq), bi = *(const f32x4*)(b_im + (g * 64 + p) * 16 + 4 * cq);
        o0 += xr * br[0] - xi * bi[0]; o1 += xr * br[1] - xi * bi[1]; o2 += xr * br[2] - xi * bi[2]; o3 += xr * br[3] - xi * bi[3]; }
    if (tau == 0 && cq == (co >> 2)) { const float dv = Dskip[g * 16 + co]; const int k = co & 3;
        o0 += k == 0 ? dv : 0.f; o1 += k == 1 ? dv : 0.f; o2 += k == 2 ? dv : 0.f; o3 += k == 3 ? dv : 0.f; }
    u32x2 w; w.x = cvt_pk_bf16(o0, o1); w.y = cvt_pk_bf16(o2, o3); const u32x2 z = (u32x2){0u, 0u};
    bf16_t* base = TM + (size_t)g * 512 * U2LD + 128 + 4 * cq;
    for (int i = tau; i < CT; ++i) *(u32x2*)(base + (size_t)(16 * i + co) * U2LD + 16 * (i - tau)) = w;
    if (tau > 0) for (int i = 0; i + tau < CT; ++i) *(u32x2*)(base + (size_t)(16 * i + co) * U2LD + 16 * (i + tau)) = z;
}
__device__ __forceinline__ void p0_tstate(const float* lam_re, const float* lam_im, const float* log_dt, const float* c_re, const float* c_im, bf16_t* TM, int g, int i, int lane) {
    float er, ei; ssm_pow(lam_re, lam_im, log_dt, g, lane, i + 1, false, er, ei);
    for (int co = 0; co < 16; ++co) { const float cr = c_re[(g * 16 + co) * 64 + lane], ci = c_im[(g * 16 + co) * 64 + lane];
        bf16_t* row = TM + ((size_t)g * 512 + 16 * i + co) * U2LD; row[lane] = (bf16_t)f2bf(cr * er - ci * ei); row[64 + lane] = (bf16_t)f2bf(-(cr * ei + ci * er)); }
}
__device__ __forceinline__ void p0_hmat(const float* lam_re, const float* lam_im, const float* log_dt, const float* b_re, const float* b_im, bf16_t* HM, int g, int i, int lane) {
    float wr, wi; ssm_pow(lam_re, lam_im, log_dt, g, lane, CT - 1 - i, true, wr, wi);
    f32x4 br[4], bi[4];
#pragma unroll
    for (int j = 0; j < 4; ++j) { br[j] = *(const f32x4*)(b_re + (g * 64 + lane) * 16 + 4 * j); bi[j] = *(const f32x4*)(b_im + (g * 64 + lane) * 16 + 4 * j); }
    bf16_t* r0 = HM + ((size_t)g * 128 + lane) * 512 + 16 * i; bf16_t* r1 = r0 + (size_t)64 * 512;
    *(u32x4*)r0 = pack8(br[0] * wr - bi[0] * wi, br[1] * wr - bi[1] * wi); *(u32x4*)(r0 + 8) = pack8(br[2] * wr - bi[2] * wi, br[3] * wr - bi[3] * wi);
    *(u32x4*)r1 = pack8(br[0] * wi + bi[0] * wr, br[1] * wi + bi[1] * wr); *(u32x4*)(r1 + 8) = pack8(br[2] * wi + bi[2] * wr, br[3] * wi + bi[3] * wr);
}

__device__ __forceinline__ int crow(int r, int hi) { return (r & 3) + 8 * (r >> 2) + 4 * hi; }
struct AttTile { size_t hb; int rb, j0, tl0, dil, kt0, mode, b, hh, quarter; float slope2; };
__device__ __forceinline__ AttTile att_tile_params(int t, int wid, int vcu, int bx, int G) {
    AttTile P; const int ui = t / 6, rnd = (t % 6) >> 1, w = wid + 8 * (t & 1);
    int pair, quarter;
    if (G == 256) { pair = bx & 127; quarter = (bx >= 128) ? (ui == 0 ? 1 : 2) : (ui == 0 ? 3 : 0); }
    else { const int un = bx + ui * G; pair = un >> 2; quarter = un & 3; }
    P.b = pair >> 3; P.hh = pair & 7; P.quarter = quarter; P.mode = rnd;
    const int g = 2 - rnd;
    P.dil = rnd == 0 ? 16 : (rnd == 1 ? 4 : 1);
    if (rnd == 0) { P.rb = 128 * w; P.j0 = 32 * quarter; P.tl0 = w; }
    else if (rnd == 1) { const int r = w & 3, jb = w >> 2; P.rb = 512 * r; P.j0 = 128 * quarter + 32 * jb; P.tl0 = 128 * jb + r; }
    else { P.rb = 0; P.j0 = 512 * quarter + 32 * w; P.tl0 = 32 * w; }
    P.hb = (size_t)(P.b * NHEADS + 8 * g + P.hh) * SEQ * HD;
    P.kt0 = (P.j0 >= 128) ? 0 : 4 - (P.j0 >> 5);
    P.slope2 = __builtin_amdgcn_exp2f(-(float)(3 * P.hh + g + 1) * (1.0f / 3.0f)) * (float)P.dil * LOG2E;
    return P;
}
__device__ __forceinline__ void attn_phase(const bf16_t* Qb, const bf16_t* Kb, const bf16_t* Vb, bf16_t* OATT, LAS unsigned char* lds, float m0, int ntiles, int wid, int lane, int vcu, int bx, int G) {
    LAS unsigned char* nums = lds; LAS float* dens = (LAS float*)(lds + 65536); LAS unsigned char* vb = lds + 67584 + wid * VT_BYTES;
    const int q = lane & 31, hi = lane >> 5;
    const int vlo = hi * 256 + ((q & 7) * 4 + (q >> 3)) * 8;
    AttTile P = att_tile_params(0, wid, vcu, bx, G);
    bf16x8 qf[4], qn[4], kf[4]; u32x4 vv[4];
#define ATT_LOADQ(QF, PP) do { const bf16_t* qp_ = Qb + (PP).hb + (size_t)((PP).rb + (PP).j0) * HD + lane * 8; \
        _Pragma("unroll") for (int ks = 0; ks < 4; ++ks) QF[ks] = *(const bf16x8*)(qp_ + ks * 512); } while (0)
#define ATT_LOADKV(PP, KT) do { const int k0_ = (PP).j0 - 128 + 32 * (KT); const bf16_t* kp_ = Kb + (PP).hb + (size_t)((PP).rb + k0_) * HD + lane * 8; \
        _Pragma("unroll") for (int ks = 0; ks < 4; ++ks) kf[ks] = *(const bf16x8*)(kp_ + ks * 512); \
        const bf16_t* vp_ = Vb + (PP).hb + (size_t)((PP).rb + k0_) * HD + vlo; \
        _Pragma("unroll") for (int c = 0; c < 4; ++c) vv[c] = *(const u32x4*)(vp_ + c * 512); } while (0)
    ATT_LOADQ(qf, P); ATT_LOADKV(P, P.kt0);
#pragma unroll 1
    for (int t = 0; t < ntiles; ++t) {
        const AttTile Pn = att_tile_params(t + 1 < ntiles ? t + 1 : t, wid, vcu, bx, G);
        if (t > 0 && (t & 1) == 0) { asm volatile("s_waitcnt lgkmcnt(0)" ::: "memory"); __builtin_amdgcn_s_barrier(); asm volatile("" ::: "memory"); }
        const int tl = P.tl0 + q * P.dil;
        LAS unsigned char* np = nums + tl * 128 + 8 * hi;
        const int nsw = ((tl ^ (tl >> 2) ^ (tl >> 4)) & 7) * 16;
        f32x16 o0 = {}, o1 = {}; float den = 0.f;
        if (P.mode != 0) {
            if (hi == 0) den = dens[tl];
#pragma unroll
            for (int rq = 0; rq < 4; ++rq) { const u32x2 a = *(const LAS u32x2*)(np + ((16 * rq) ^ nsw)), b = *(const LAS u32x2*)(np + ((64 + 16 * rq) ^ nsw));
                o0[4 * rq] = bf_lo(a.x); o0[4 * rq + 1] = bf_hi(a.x); o0[4 * rq + 2] = bf_lo(a.y); o0[4 * rq + 3] = bf_hi(a.y);
                o1[4 * rq] = bf_lo(b.x); o1[4 * rq + 1] = bf_hi(b.x); o1[4 * rq + 2] = bf_lo(b.y); o1[4 * rq + 3] = bf_hi(b.y); }
        }
#pragma unroll 1
        for (int kt = P.kt0; kt <= 4; ++kt) {
            f32x16 s = {};
#pragma unroll
            for (int ks = 0; ks < 4; ++ks) s = __builtin_amdgcn_mfma_f32_32x32x16_bf16(kf[ks], qf[ks], s, 0, 0, 0);
            u32x4 vc[4];
#pragma unroll
            for (int c = 0; c < 4; ++c) vc[c] = vv[c];
            { const bool last = kt == 4; const size_t hbn = last ? Pn.hb : P.hb; const int rown = last ? Pn.rb + Pn.j0 - 128 + 32 * Pn.kt0 : P.rb + P.j0 - 128 + 32 * (kt + 1);
              const bf16_t* kp_ = Kb + hbn + (size_t)rown * HD + lane * 8;
#pragma unroll
              for (int ks = 0; ks < 4; ++ks) kf[ks] = *(const bf16x8*)(kp_ + ks * 512);
              const bf16_t* vp_ = Vb + hbn + (size_t)rown * HD + vlo;
#pragma unroll
              for (int c = 0; c < 4; ++c) vv[c] = *(const u32x4*)(vp_ + c * 512);
              if (last) ATT_LOADQ(qn, Pn); }
            __builtin_amdgcn_sched_barrier(0);
            const int dq = 128 - 32 * kt + q;
            const float base = -P.slope2 * (float)dq - m0;
            float p[16];
#pragma unroll
            for (int rr = 0; rr < 16; ++rr) { const int key = crow(rr, hi); float v = s[rr] + base + P.slope2 * (float)key;
                if (kt == 0) { if (dq - key > 128) v = -__builtin_inff(); }
                if (kt == 4) { if (dq - key < 0) v = -__builtin_inff(); }
                p[rr] = __builtin_amdgcn_exp2f(v); den += p[rr]; }
            u32x4 pw0, pw1;
            pw0.x = cvt_pk_bf16(p[0], p[1]); pw0.y = cvt_pk_bf16(p[2], p[3]); pw0.z = cvt_pk_bf16(p[4], p[5]); pw0.w = cvt_pk_bf16(p[6], p[7]);
            pw1.x = cvt_pk_bf16(p[8], p[9]); pw1.y = cvt_pk_bf16(p[10], p[11]); pw1.z = cvt_pk_bf16(p[12], p[13]); pw1.w = cvt_pk_bf16(p[14], p[15]);
            const bf16x8 pb0 = __builtin_bit_cast(bf16x8, pw0), pb1 = __builtin_bit_cast(bf16x8, pw1);
#pragma unroll
            for (int db = 0; db < 2; ++db)
#pragma unroll
                for (int sk = 0; sk < 2; ++sk) {
                    const bf16x8 vf = __builtin_bit_cast(bf16x8, vc[db * 2 + sk]);
                    if (db == 0) o0 = __builtin_amdgcn_mfma_f32_32x32x16_bf16(vf, sk == 0 ? pb0 : pb1, o0, 0, 0, 0);
                    else         o1 = __builtin_amdgcn_mfma_f32_32x32x16_bf16(vf, sk == 0 ? pb0 : pb1, o1, 0, 0, 0);
                }
        }
        den += __shfl_xor(den, 32);
        if (P.mode != 2) {
            if (hi == 0) dens[tl] = den;
#pragma unroll
            for (int db = 0; db < 2; ++db)
#pragma unroll
                for (int rq = 0; rq < 4; ++rq) { u32x2 w; const f32x16& o = db == 0 ? o0 : o1; w.x = cvt_pk_bf16(o[4 * rq], o[4 * rq + 1]); w.y = cvt_pk_bf16(o[4 * rq + 2], o[4 * rq + 3]); *(LAS u32x2*)(np + ((db * 64 + 16 * rq) ^ nsw)) = w; }
        } else {
            const float inv = __builtin_amdgcn_rcpf(den);
#pragma unroll
            for (int db = 0; db < 2; ++db)
#pragma unroll
                for (int rq = 0; rq < 4; ++rq) { u32x2 w; const f32x16& o = db == 0 ? o0 : o1; w.x = cvt_pk_bf16(o[4 * rq] * inv, o[4 * rq + 1] * inv); w.y = cvt_pk_bf16(o[4 * rq + 2] * inv, o[4 * rq + 3] * inv);
                    *(LAS u32x2*)(vb + q * 128 + db * 64 + 16 * rq + 8 * hi) = w; }
            const int orow = P.b * SEQ + 512 * P.quarter + P.tl0;
#pragma unroll
            for (int c = 0; c < 4; ++c) { const int x = c * 64 + lane, r_ = x >> 3; const u32x4 v = *(const LAS u32x4*)(vb + r_ * 128 + (x & 7) * 16);
                *(u32x4*)(OATT + blk_idx<AOUT>(orow + r_, P.hh * 64 + (x & 7) * 8)) = v; }
        }
#pragma unroll
        for (int ks = 0; ks < 4; ++ks) qf[ks] = qn[ks];
        P = Pn;
    }
#undef ATT_LOADQ
#undef ATT_LOADKV
}

#define XB_TMO      128
#define XB_XCNT(j)  (256  + 64 * (j))
#define XB_XSUB(j)  (1280 + 64 * (j))
#define XB_XGEN(j)  (2304 + 64 * (j))
#define XB_TOP      3328
#define XB_TOPGEN   3392
#define XCD_BAR_WORDS 3456
#define XB_SPIN_CAP (1u << 18)

__device__ __forceinline__ unsigned xb_ld(unsigned* p)              { return __hip_atomic_load(p, __ATOMIC_RELAXED, __HIP_MEMORY_SCOPE_AGENT); }
__device__ __forceinline__ unsigned xb_add(unsigned* p, unsigned v) { return __hip_atomic_fetch_add(p, v, __ATOMIC_RELAXED, __HIP_MEMORY_SCOPE_AGENT); }
__device__ __forceinline__ unsigned xb_xcc_id() { return (unsigned)__builtin_amdgcn_s_getreg((3 << 11) | 20) & 0xFu; }
#define XB_SPIN(cond, bar) do { unsigned _sp = 0; while (cond) { __builtin_amdgcn_s_sleep(1); \
    if ((++_sp & 255u) == 0u) { if (xb_ld(&(bar)[XB_TMO])) break; if (_sp > XB_SPIN_CAP) { atomicAdd(&(bar)[XB_TMO], 1u); break; } } } } while (0)

struct XcdBarrier {
    unsigned* bar; unsigned x;
    volatile LAS unsigned* st;
};

__device__ __forceinline__ XcdBarrier xcd_barrier_post(unsigned* bar, volatile LAS unsigned* st) {
    XcdBarrier b; b.bar = bar; b.x = xb_xcc_id(); b.st = st;
    if (threadIdx.x == 0) (void)xb_add(&bar[XB_XCNT(b.x)], 1u);
    return b;
}
__device__ __forceinline__ void xcd_barrier_complete(unsigned* bar, unsigned x, unsigned& nloc, unsigned& nx) {
    const unsigned G = gridDim.x * gridDim.y * gridDim.z;
    unsigned sum, cnt, mine, sp = 0u;
    for (;;) {
        sum = 0u; cnt = 0u; mine = 0u;
#pragma unroll
        for (unsigned j = 0; j < 16; ++j) { const unsigned c = xb_ld(&bar[XB_XCNT(j)]); sum += c; cnt += (c > 0u) ? 1u : 0u; mine = (j == x) ? c : mine; }
        if (sum == G) break;
        __builtin_amdgcn_s_sleep(1);
        if ((++sp & 255u) == 0u) { if (xb_ld(&bar[XB_TMO])) break; if (sp > XB_SPIN_CAP) { atomicAdd(&bar[XB_TMO], 1u); break; } }
    }
    nloc = mine > 0u ? mine : 1u; nx = cnt > 0u ? cnt : 1u;
}

__device__ __forceinline__ void xcd_barrier(const XcdBarrier& b) {
    asm volatile("s_waitcnt vmcnt(0)" ::: "memory");
    __syncthreads();
    if (threadIdx.x == 0) {
        unsigned* bar = b.bar;
        __builtin_amdgcn_s_waitcnt(0);
        unsigned nloc = b.st[0], nx = b.st[1];
        if (nloc == 0u) { xcd_barrier_complete(bar, b.x, nloc, nx); b.st[0] = nloc; b.st[1] = nx; }
        const unsigned old = xb_add(&bar[XB_XSUB(b.x)], 1u);
        const unsigned gen = old / nloc;
        if (old + 1u == (gen + 1u) * nloc) {
            __builtin_amdgcn_fence(__ATOMIC_RELEASE, "agent");
            asm volatile("s_waitcnt vmcnt(0)" ::: "memory");
            const unsigned og = xb_add(&bar[XB_TOP], 1u);
            const unsigned tg = og / nx;
            if (og + 1u == (tg + 1u) * nx) xb_add(&bar[XB_TOPGEN], 1u);
            else XB_SPIN(xb_ld(&bar[XB_TOPGEN]) == tg, bar);
            __builtin_amdgcn_fence(__ATOMIC_ACQUIRE, "agent");
            xb_add(&bar[XB_XGEN(b.x)], 1u);
            asm volatile("s_waitcnt vmcnt(0)" ::: "memory");
        } else {
            XB_SPIN(xb_ld(&bar[XB_XGEN(b.x)]) == gen, bar);
            __builtin_amdgcn_fence(__ATOMIC_ACQUIRE, "agent");
            asm volatile("s_waitcnt vmcnt(0)" ::: "memory");
        }
    }
    __syncthreads();
}

struct Args {
    const float* in[23]; float* out; unsigned char* ws; int ph_lo, ph_hi;
};
enum { I_X = 0, I_NMG, I_WIN, I_LRE, I_LIM, I_LDT, I_BRE, I_BIM, I_CRE, I_CIM, I_D, I_GLV, I_GLG, I_QG, I_KG, I_WUP, I_WOUT, I_NFG, I_FWG, I_FWU, I_CW, I_CB, I_WDN };
constexpr int NPHASE = 8;
#ifndef MK_COOP
#define MK_COOP 1
#endif

__global__ void __launch_bounds__(512, 2) hybrid_fwd(Args args) {
    extern __shared__ __attribute__((aligned(16))) unsigned char lds_raw[];
    LAS unsigned char* lds = (LAS unsigned char*)lds_raw;
    const int tid = threadIdx.x, lane = tid & 63, wid = __builtin_amdgcn_readfirstlane(tid >> 6);
    const int G = gridDim.x, bx = blockIdx.x, vcu = (G % 8 == 0) ? (bx % 8) * (G / 8) + bx / 8 : bx;
    unsigned char* ws = args.ws; unsigned char* dob = (unsigned char*)args.out;
    const int lo = args.ph_lo, hi = args.ph_hi;
    volatile LAS unsigned* MISC = (volatile LAS unsigned*)(lds + LDS_MISC);
    if (tid < 16) MISC[tid] = 0u;
    __syncthreads();
    XcdBarrier bar; bar.bar = (unsigned*)ws; bar.x = 0; bar.st = nullptr;
#if MK_COOP
    bar = xcd_barrier_post((unsigned*)ws, MISC);
#endif
#define IN(k) (lo <= (k) && (k) < hi)
#if MK_COOP
#define SEAM(k) do { if (IN(k) && IN((k) + 1)) { xcd_barrier(bar); } } while (0)
#else
#define SEAM(k) do { } while (0)
#endif
    bf16_t* const WIN = (bf16_t*)(ws + WS_WIN); bf16_t* const WGLU = (bf16_t*)(ws + WS_WGLU); bf16_t* const WUP = (bf16_t*)(ws + WS_WUP); bf16_t* const WOUT = (bf16_t*)(ws + WS_WOUT);
    bf16_t* const WGU = (bf16_t*)(ws + WS_WGU); bf16_t* const WDN = (bf16_t*)(ws + WS_WDN); bf16_t* const TMAT = (bf16_t*)(ws + WS_TMAT); bf16_t* const HMAT = (bf16_t*)(ws + WS_HMAT);
    float* const SS = (float*)(ws + WS_SS); f32x2* const APOW = (f32x2*)(ws + WS_APOW);
    bf16_t* const GA = (bf16_t*)(ws + WS_GA); bf16_t* const GB = (bf16_t*)(ws + WS_GB);
    bf16_t* const Qb = (bf16_t*)(ws + WS_Q); bf16_t* const Kb = (bf16_t*)(ws + WS_K); bf16_t* const Vb = (bf16_t*)(ws + WS_V);
    bf16_t* const YSSM = (bf16_t*)(ws + WS_YSSM); bf16_t* const TMPB = (bf16_t*)(ws + WS_TMPB); bf16_t* const MERGED = (bf16_t*)(ws + WS_MERGED); bf16_t* const X1B = (bf16_t*)(ws + WS_X1B); bf16_t* const HB = (bf16_t*)(ws + WS_H);
    float* const TAIL = (float*)(ws + WS_TAIL); float* const HEADG = (float*)(ws + WS_HEADG); float* const HEADU = (float*)(ws + WS_HEADU);
    bf16_t* const XN = (bf16_t*)(dob + DO_XN); bf16_t* const U2 = (bf16_t*)(dob + DO_U2); bf16_t* const OATT = (bf16_t*)(ws + WS_GA + 32 * MiB);
    float* const RINV = (float*)(ws + WS_RINV);
    float* const OUT = args.out;

    if (IN(0)) {
        LAS float* scr = (LAS float*)(lds + wid * 16384);
        const bool swv = wid < 5; const int gw = swv ? vcu * 5 + wid : vcu * 3 + (wid - 5), NGW = swv ? G * 5 : G * 3;
        constexpr int XSPLIT = 3 * MTOK / 4;
        constexpr int I_IN = 16 * (NIN / 32), I_GL = 8 * (2048 / 32), I_UP = 8 * (1024 / 32), I_OU = 16 * (1024 / 32), I_GU = 16 * (2 * DFF / 32), I_DN = (DFF / 64) * (1024 / 32);
        constexpr int NW = I_IN + I_GL + I_UP + I_OU + I_GU + I_DN;
        for (int it = swv ? NW : gw; it < NW; it += NGW) {
            int r = it;
            if (r < I_IN) { p0_transpose_item(args.in[I_WIN], nullptr, NIN, DM, NIN, WIN, args.in[I_NMG], 1, scr, r, lane, -LOG2E); continue; } r -= I_IN;
            if (r < I_GL) { p0_transpose_item(args.in[I_GLV], args.in[I_GLG], DM, SSMW, 2048, WGLU, nullptr, 2, scr, r, lane, -LOG2E); continue; } r -= I_GL;
            if (r < I_UP) { p0_transpose_item(args.in[I_WUP], nullptr, DM, AOUT, DM, WUP, nullptr, 0, scr, r, lane); continue; } r -= I_UP;
            if (r < I_OU) { p0_transpose_item(args.in[I_WOUT], nullptr, DM, DM, DM, WOUT, nullptr, 0, scr, r, lane); continue; } r -= I_OU;
            if (r < I_GU) { p0_transpose_item(args.in[I_FWG], args.in[I_FWU], DFF, DM, 2 * DFF, WGU, args.in[I_NFG], 2, scr, r, lane); continue; } r -= I_GU;
            p0_transpose_item(args.in[I_WDN], nullptr, DM, DFF, DM, WDN, nullptr, 0, scr, r, lane);
        }
        for (int it = swv ? gw : 3 * 1024 + 32 + 1; it < 3 * 1024 + 32 + 1; it += NGW) {
            if (it < 1024) p0_toeplitz(args.in[I_LRE], args.in[I_LIM], args.in[I_LDT], args.in[I_BRE], args.in[I_BIM], args.in[I_CRE], args.in[I_CIM], args.in[I_D], TMAT, it >> 5, it & 31, lane);
            else if (it < 2048) p0_tstate(args.in[I_LRE], args.in[I_LIM], args.in[I_LDT], args.in[I_CRE], args.in[I_CIM], TMAT, (it - 1024) >> 5, it & 31, lane);
            else if (it < 3072) p0_hmat(args.in[I_LRE], args.in[I_LIM], args.in[I_LDT], args.in[I_BRE], args.in[I_BIM], HMAT, (it - 2048) >> 5, it & 31, lane);
            else if (it < 3104) { float ar, ai; ssm_pow(args.in[I_LRE], args.in[I_LIM], args.in[I_LDT], it - 3072, lane, CT, false, ar, ai); APOW[(it - 3072) * 64 + lane] = (f32x2){ar, ai}; }
            else { for (int j = lane; j < 128 * 512 / 8; j += 64) *(u32x4*)(HMAT + (size_t)32 * 128 * 512 + (size_t)j * 8) = (u32x4){0u, 0u, 0u, 0u}; }
        }
        for (int j = vcu * 512 + tid; j < MTOK; j += G * 512) SS[j] = 0.f;
        const float* X = args.in[I_X];
        for (int m0 = (swv ? XSPLIT : 0) + gw * 4; m0 < (swv ? MTOK : XSPLIT); m0 += NGW * 4) {
            f32x4 v[4][4]; float s[4];
#pragma unroll
            for (int rr = 0; rr < 4; ++rr) { const f32x4* xr = (const f32x4*)(X + (size_t)(m0 + rr) * DM) + lane;
#pragma unroll
                for (int j = 0; j < 4; ++j) v[rr][j] = xr[64 * j]; }
#pragma unroll
            for (int rr = 0; rr < 4; ++rr) { float a = 0.f;
#pragma unroll
                for (int j = 0; j < 4; ++j) a += (v[rr][j][0] * v[rr][j][0] + v[rr][j][1] * v[rr][j][1]) + (v[rr][j][2] * v[rr][j][2] + v[rr][j][3] * v[rr][j][3]);
                s[rr] = a; }
#pragma unroll
            for (int o = 1; o < 64; o <<= 1) {
#pragma unroll
                for (int rr = 0; rr < 4; ++rr) s[rr] += __shfl_xor(s[rr], o); }
#pragma unroll
            for (int rr = 0; rr < 4; ++rr) { const float rs = __builtin_amdgcn_rsqf(s[rr] * (1.0f / DM) + EPS); u32x2* o = (u32x2*)(XN + (size_t)(m0 + rr) * DM) + lane;
                if (lane == 0) RINV[m0 + rr] = __builtin_sqrtf(s[rr] * (1.0f / DM) + EPS);
#pragma unroll
                for (int j = 0; j < 4; ++j) { u32x2 w; w.x = cvt_pk_bf16(v[rr][j][0] * rs, v[rr][j][1] * rs); w.y = cvt_pk_bf16(v[rr][j][2] * rs, v[rr][j][3] * rs); o[64 * j] = w; } }
        }
        asm volatile("s_waitcnt vmcnt(0) lgkmcnt(0)" ::: "memory"); __syncthreads();
    }
    SEAM(0);

    if (IN(1)) {
        pg8::Gemm g{XN, WIN, DM, DM, DM}; pg8::StaticOrder<0> S; S.init(MTOK / 256, NIN / 256, G, bx);
        S.inproj = true;
        EpiInProj E{U2, Qb, Kb, Vb, GA, GB, args.in[I_QG], args.in[I_KG]};
        pg8::gemm_phase<EpiInProj, pg8::StaticOrder<0>, true, true>(lds, g, S, E);
    }
    SEAM(1);

    if (IN(2)) {
        { pg8::Gemm g{U2 + 128, HMAT, CT * GCH, U2LD, CT * GCH}; pg8::StaticOrder<1> S; S.init(128, 1, G, bx);
          EpiSsmState E{U2, APOW};
          pg8::gemm_phase<EpiSsmState, pg8::StaticOrder<1>, false, true>(lds, g, S, E); }
        __syncthreads();
        const float m0 = 8.0f * LOG2E * wave_max(fabsf(args.in[I_QG][lane])) * wave_max(fabsf(args.in[I_KG][lane]));
        const int nun = (G == 256) ? 2 : (512 - bx + G - 1) / G;
        attn_phase(Qb, Kb, Vb, OATT, lds, m0, 6 * nun, wid, lane, vcu, bx, G);
        asm volatile("s_waitcnt vmcnt(0) lgkmcnt(0)" ::: "memory"); __syncthreads();
    }
    SEAM(2);

    if (IN(3)) {
        { pg8::Gemm g{U2, TMAT, U2LD, U2LD, U2LD}; pg8::StaticOrder<2> S; S.init(128, 2, G, bx);
          EpiSsmOut E{YSSM};
          pg8::gemm_phase<EpiSsmOut, pg8::StaticOrder<2>, true, true>(lds, g, S, E); }
        __syncthreads();
        { pg8::Gemm g{OATT, WUP, AOUT, AOUT, AOUT, 1}; pg8::StaticOrder<0> S; S.init(MTOK / 256, DM / 256, G, bx);
          EpiUp E{GB, TMPB};
          pg8::gemm_phase<EpiUp, pg8::StaticOrder<0>, true, true>(lds, g, S, E); }
    }
    SEAM(3);

    if (IN(4)) {
        pg8::Gemm g{YSSM, WGLU, SSMW, SSMW, SSMW, 1}; pg8::StaticOrder<0> S; S.init(MTOK / 256, 2048 / 256, G, bx);
        EpiGlu E{GA, TMPB, MERGED};
        pg8::gemm_phase<EpiGlu, pg8::StaticOrder<0>, true, true>(lds, g, S, E);
    }
    SEAM(4);

    if (IN(5)) {
        pg8::Gemm g{MERGED, WOUT, DM, DM, DM, 1}; pg8::StaticOrder<0> S; S.init(MTOK / 256, DM / 256, G, bx);
        EpiOut E{XN, RINV, X1B, SS};
        pg8::gemm_phase<EpiOut, pg8::StaticOrder<0>, true, true>(lds, g, S, E);
    }
    SEAM(5);

    if (IN(6)) {
        pg8::Gemm g{X1B, WGU, DM, DM, DM}; pg8::StaticOrder<0> S; S.init(MTOK / 256, 2 * DFF / 256, G, bx);
        EpiFfn E{SS, args.in[I_CW], args.in[I_CB], HB, TAIL, HEADG, HEADU, (LAS float*)(lds + LDS_HALO)};
        pg8::gemm_phase<EpiFfn, pg8::StaticOrder<0>, true, true>(lds, g, S, E);
    }
    SEAM(6);

    if (IN(7)) {
        pg8::Gemm g{HB, WDN, DFF, DFF, DFF, 1}; pg8::StaticOrder<0> S; S.init(MTOK / 256, DM / 256, G, bx);
        { const float* cw = args.in[I_CW]; const float* cb = args.in[I_CB]; pg8::Unit uu;
          for (int i = 0; S.next(i, uu); ++i) { const int pm = uu.pm; if ((pm & 7) == 0) continue;
            for (int f = tid; f < DFF; f += 512) {
                const float g0 = HEADG[((size_t)pm * 2) * DFF + f], g1 = HEADG[((size_t)pm * 2 + 1) * DFF + f], ta = TAIL[((size_t)(pm - 1) * 2) * DFF + f], tb = TAIL[((size_t)(pm - 1) * 2 + 1) * DFF + f];
                const float w0 = cw[f], w1 = cw[DFF + f], w2 = cw[2 * DFF + f], bb = cb[f];
                const f32x2 gl = gelu_pk((f32x2){w2 * g0 + w1 * tb + w0 * ta + bb, w2 * g1 + w1 * g0 + w0 * tb + bb});
                HB[h_idx(pm * 256, f)] = (bf16_t)f2bf(gl.x * HEADU[((size_t)pm * 2) * DFF + f]);
                HB[h_idx(pm * 256 + 1, f)] = (bf16_t)f2bf(gl.y * HEADU[((size_t)pm * 2 + 1) * DFF + f]); } }
          asm volatile("s_waitcnt vmcnt(0)" ::: "memory"); __syncthreads(); }
        EpiDown E{X1B, OUT};
        pg8::gemm_phase<EpiDown, pg8::StaticOrder<0>, true, true>(lds, g, S, E);
    }
#undef IN
#undef SEAM
}

extern "C" void kernel_launch(void* const* d_in, const int* in_sizes, int n_in, void* d_out, int out_size, void* d_ws, size_t ws_size, hipStream_t stream) {
    static int grid = 0;
    if (grid == 0) {
        if (n_in != 23 || out_size != MTOK * DM || ws_size < WS_END) { fprintf(stderr, "kernel_launch: unexpected problem (n_in %d, out %d, ws %zu < %zu)\n", n_in, out_size, ws_size, (size_t)WS_END); grid = -1; return; }
        int dev = 0, cus = 0, per_cu = 0;
        (void)hipGetDevice(&dev); (void)hipDeviceGetAttribute(&cus, hipDeviceAttributeMultiprocessorCount, dev);
        if (hipFuncSetAttribute((const void*)hybrid_fwd, hipFuncAttributeMaxDynamicSharedMemorySize, LDS_BYTES) != hipSuccess) { fprintf(stderr, "kernel_launch: hipFuncSetAttribute failed\n"); grid = -1; return; }
        if (hipOccupancyMaxActiveBlocksPerMultiprocessor(&per_cu, (const void*)hybrid_fwd, 512, LDS_BYTES) != hipSuccess || per_cu < 1) { fprintf(stderr, "kernel_launch: the occupancy query admits %d workgroups per CU for this kernel and LDS size; the grid barrier needs one resident workgroup per CU; nothing launched\n", per_cu); grid = -1; return; }
        (void)hipGetLastError();
        grid = cus;
        if (grid != 256) fprintf(stderr, "kernel_launch: %d CUs (expected 256)\n", grid);
        if (grid < 128) { fprintf(stderr, "kernel_launch: the S5 chunk-state phase needs at least 128 workgroups (one unit each); nothing launched\n"); grid = -1; return; }
    }
    if (grid < 0) return;
    Args a{};
    for (int i = 0; i < 23; ++i) a.in[i] = (const float*)d_in[i];
    a.out = (float*)d_out; a.ws = (unsigned char*)d_ws;
#if MK_COOP
    if (hipMemsetAsync(d_ws, 0, 16384, stream) != hipSuccess) { fprintf(stderr, "kernel_launch: memset of the barrier words failed\n"); return; }
    a.ph_lo = 0; a.ph_hi = NPHASE;
    void* kargs[] = {&a};
    hipError_t e = hipLaunchCooperativeKernel((const void*)hybrid_fwd, dim3(grid), dim3(512), kargs, LDS_BYTES, stream);
    if (e != hipSuccess) fprintf(stderr, "kernel_launch: cooperative launch failed: %s (grid %d)\n", hipGetErrorString(e), grid);
#else
    for (int ph = 0; ph < NPHASE; ++ph) { a.ph_lo = ph; a.ph_hi = ph + 1; hipLaunchKernelGGL(hybrid_fwd, dim3(grid), dim3(512), LDS_BYTES, stream, a); }
#endif
}
```

```cpp
#include <hip/hip_runtime.h>
#include <hip/hip_cooperative_groups.h>
#include <cstdio>
#include <cstdint>
namespace cg = cooperative_groups;

#define LAS __attribute__((address_space(3)))
#define PG8_LAS LAS
typedef unsigned short bf16_t;
typedef short bf16x8 __attribute__((ext_vector_type(8)));
typedef short s16x4 __attribute__((ext_vector_type(4)));
typedef float f32x2 __attribute__((ext_vector_type(2)));
typedef float f32x4 __attribute__((ext_vector_type(4)));
typedef float f32x16 __attribute__((ext_vector_type(16)));
typedef unsigned u32x2 __attribute__((ext_vector_type(2)));
typedef unsigned u32x4 __attribute__((ext_vector_type(4)));

constexpr int BATCH = 16, SEQ = 2048, DM = 1024, MTOK = BATCH * SEQ;
constexpr int SSMW = 512, NGRP = 32, NST = 64, GCH = 16;
constexpr int AW = 1536, NHEADS = 24, HD = 64, AOUT = 512;
constexpr int NIN = 7168, DFF = 2816;
constexpr int CT = 32, NCH = SEQ / CT;
constexpr int U2LD = 128 + CT * GCH;
constexpr float EPS = 1e-6f;
constexpr float LOG2E = 1.4426950408889634f;

constexpr size_t MiB = 1u << 20;
constexpr size_t WS_SS = 512 * 1024;
constexpr size_t WS_RINV = 640 * 1024;
constexpr size_t WS_APOW = 768 * 1024;
constexpr size_t WS_WIN = 1 * MiB, WS_WGLU = 15 * MiB, WS_WUP = 17 * MiB, WS_WOUT = 18 * MiB, WS_WGU = 20 * MiB, WS_WDN = 31 * MiB;
constexpr size_t WS_TMAT = 37 * MiB;
constexpr size_t WS_HMAT = 57 * MiB;
constexpr size_t WS_TAIL = 62 * MiB, WS_HEADG = 65 * MiB, WS_HEADU = 68 * MiB;
constexpr size_t WS_GA = 72 * MiB, WS_GB = 136 * MiB;
constexpr size_t WS_Q = 200 * MiB, WS_K = 296 * MiB, WS_V = 392 * MiB;
constexpr size_t WS_END = 488 * MiB;
constexpr size_t WS_YSSM = WS_Q, WS_TMPB = WS_Q + 32 * MiB, WS_MERGED = WS_Q + 96 * MiB, WS_X1B = WS_Q + 176 * MiB, WS_H = WS_Q;
constexpr size_t DO_XN = 0;
constexpr size_t DO_SCR = 0;
constexpr size_t DO_U2 = 80 * MiB;

constexpr int LDS_BYTES = 163840;
constexpr int ZS = 132;
constexpr int LDS_HALO = 139264;
constexpr int LDS_MISC = 143360;
constexpr int VT_BYTES = 32 * 192;

typedef __bf16 bf16x2_t __attribute__((ext_vector_type(2)));
__device__ __forceinline__ unsigned cvt_pk_bf16(float lo, float hi) { const f32x2 v = {lo, hi}; const bf16x2_t b = __builtin_convertvector(v, bf16x2_t); return __builtin_bit_cast(unsigned, b); }
__device__ __forceinline__ float bf_lo(unsigned w) { return __uint_as_float(w << 16); }
__device__ __forceinline__ float bf_hi(unsigned w) { return __uint_as_float(w & 0xffff0000u); }
__device__ __forceinline__ unsigned f2bf(float f) { unsigned u = __float_as_uint(f); return (u + 0x7fffu + ((u >> 16) & 1u)) >> 16; }
__device__ __forceinline__ float sigmoidp_(float x) { return __builtin_amdgcn_rcpf(1.0f + __builtin_amdgcn_exp2f(x)); }
__device__ __forceinline__ unsigned gate4_u8(f32x4 x) { const unsigned a = (unsigned)(sigmoidp_(x[0]) * 255.0f + 0.5f), b = (unsigned)(sigmoidp_(x[1]) * 255.0f + 0.5f), c = (unsigned)(sigmoidp_(x[2]) * 255.0f + 0.5f), d = (unsigned)(sigmoidp_(x[3]) * 255.0f + 0.5f);
    return a | (b << 8) | (c << 16) | (d << 24); }
__device__ __forceinline__ f32x4 gate4_f32(unsigned w) { return (f32x4){(float)(w & 255u), (float)((w >> 8) & 255u), (float)((w >> 16) & 255u), (float)(w >> 24)} * (1.0f / 255.0f); }
__device__ __forceinline__ float wave_sum(float v) {
#pragma unroll
    for (int o = 1; o < 64; o <<= 1) v += __shfl_xor(v, o);
    return v;
}
__device__ __forceinline__ float wave_max(float v) {
#pragma unroll
    for (int o = 1; o < 64; o <<= 1) v = fmaxf(v, __shfl_xor(v, o));
    return v;
}
__device__ __forceinline__ f32x2 gelu_pk(f32x2 v) {
    f32x2 n; n.x = __builtin_fmaxf(-__builtin_fabsf(v.x), -5.6f); n.y = __builtin_fmaxf(-__builtin_fabsf(v.y), -5.6f);
    f32x2 p = n * 3.360643278e-05f + 7.736645178e-04f; p = p * n + 8.095245171e-03f; p = p * n + 5.343466881e-02f; p = p * n + (-4.587538301e-01f); p = p * n + 1.151207531e+00f; p = p * n + (-9.999924068e-01f);
    f32x2 e; e.x = __builtin_amdgcn_exp2f(p.x); e.y = __builtin_amdgcn_exp2f(p.y);
    f32x2 r; r.x = __builtin_fmaxf(v.x, 0.f); r.y = __builtin_fmaxf(v.y, 0.f);
    return __builtin_elementwise_fma(n, e, r);
}
__device__ __forceinline__ f32x4 gelu4(f32x4 v) { const f32x2 a = gelu_pk((f32x2){v[0], v[1]}), b = gelu_pk((f32x2){v[2], v[3]}); return (f32x4){a.x, a.y, b.x, b.y}; }
__device__ __forceinline__ u32x4 pack8(f32x4 a, f32x4 b) { u32x4 w; w.x = cvt_pk_bf16(a[0], a[1]); w.y = cvt_pk_bf16(a[2], a[3]); w.z = cvt_pk_bf16(b[0], b[1]); w.w = cvt_pk_bf16(b[2], b[3]); return w; }
__device__ __forceinline__ void unpack8(u32x4 w, f32x4& a, f32x4& b) { a = (f32x4){bf_lo(w.x), bf_hi(w.x), bf_lo(w.y), bf_hi(w.y)}; b = (f32x4){bf_lo(w.z), bf_hi(w.z), bf_lo(w.w), bf_hi(w.w)}; }

namespace pg8 {
constexpr int BM = 256, BK = 64, HALF = 128, HTB = HALF * BK * 2  , STAGE_BYTES = 8 * HTB, NXCD = 8, WGM = 8;
__host__ __device__ __forceinline__ int lds_byte(int r, int c) { const int st = (r >> 4) * 2 + (c >> 5), rr = r & 15, cc = c & 31, ob = rr * 64 + cc * 2; return st * 1024 + (ob ^ (((ob >> 9) & 1) << 5)); }
__host__ __device__ __forceinline__ void stage_rc(int b, int& R, int& C) { const int st = b / 1024, sb = b % 1024, swz = sb ^ (((sb >> 9) & 1) << 5); R = (st >> 1) * 16 + swz / 64; C = (st & 1) * 32 + (swz % 64) / 2; }
__host__ __device__ __forceinline__ int perm32(int rho) { const int n = rho >> 4, i = rho & 15; return 8 * (i >> 2) + 4 * n + (i & 3); }

struct Unit { int pm, pn, ar, br, amode; };
struct Gemm { const bf16_t* A; const bf16_t* Bt; int K, lda, ldb; int ablk = 0; };

template <int MODE>
struct StaticOrder {
    int nM, nN, nwg, G, c; bool inproj = false;
    __device__ void init(int nM_, int nN_, int G_, int c_) { nM = nM_; nN = nN_; nwg = nM * nN; G = G_; c = c_; }
    __device__ bool next(int i, Unit& u) const {
        const long L = (long)i * G + c; if (L >= nwg) return false;
        int wgid = (int)L; { const int q = nwg / NXCD, r = nwg % NXCD, xcd = wgid % NXCD, off = wgid / NXCD; wgid = (xcd < r ? xcd * (q + 1) : r * (q + 1) + (xcd - r) * q) + off; }
        const int nig = WGM * nN, gid = wgid / nig, fm = gid * WGM, gsz = (nM - fm) < WGM ? (nM - fm) : WGM;
        u.pm = fm + ((wgid % nig) % gsz); u.pn = (wgid % nig) / gsz;
        u.ar = 256 * u.pm; u.amode = 0;
        if (inproj) { const int pn = u.pn;
            if (pn >= 14 && pn < 20) u.amode = 1 + ((pn - 14) >> 1);
            else if (pn >= 2 && pn < 14) { const int dsel = ((pn - 2) % 6) >> 1; u.amode = dsel == 2 ? 4 : (dsel == 1 ? 5 : 0); } }
        u.br = MODE == 0 ? 256 * u.pn : (MODE == 1 ? 128 * (u.pm >> 2) : 512 * (u.pm >> 2) + 256 * u.pn);
        return true;
    }
    __device__ __forceinline__ void a_ready(const Unit&) const {}
    __device__ __forceinline__ void done(const Unit&) const {}
};
template <class Epi, class Sched, bool ALIGN_EPI = false, bool SP2 = false>
__device__ __forceinline__ void gemm_phase(PG8_LAS unsigned char* lds, const Gemm g, const Sched& S, const Epi& E) {
    const int tid = threadIdx.x, wid = __builtin_amdgcn_readfirstlane(tid >> 6), lane = tid & 63, wr = wid >> 2, wc = wid & 3, fr = lane & 15, fq = lane >> 4;
    const int nt = g.K / BK, lda = g.ablk ? BK : g.lda, ldb = g.ldb;
    unsigned voffA[2], voffAn[2], voffB[2];
#pragma unroll
    for (int i = 0; i < 2; ++i) { int R, C; stage_rc(tid * 16 + i * 8192, R, C); const int Rb = Epi::PERM ? ((R & ~31) + perm32(R & 31)) : R;
        const int Ra = Epi::AROW4 ? ((R & 64) + 4 * (R & 15) + ((R >> 4) & 3)) : R;
        voffA[i] = (unsigned)(Ra * lda + C) * 2u; voffB[i] = (unsigned)(Rb * ldb + C) * 2u; }
    const size_t kstep = (size_t)(BK * 2);
    const size_t kstepA = g.ablk ? (size_t)(BM * BK * 2) : kstep, arow = g.ablk ? (size_t)g.K * 2 : (size_t)g.lda * 2;
    size_t hsA = (size_t)HALF * lda * 2, hsAn = hsA; const size_t hsB = (size_t)HALF * ldb * 2;
    auto set_amode = [&](int mode, unsigned* v, size_t& hs) {
        const int lg = mode >= 1 && mode <= 3 ? 2 * (mode - 1) : 0;
        _Pragma("unroll") for (int i = 0; i < 2; ++i) { int R, C; stage_rc(tid * 16 + i * 8192, R, C); int Ra = R;
            const int wr_ = (R >> 6) & 1, m_ = (R >> 4) & 3, fr_ = R & 15, hi_ = fr_ & 1, cs_ = 8 * wr_ + (fr_ >> 1);
            if (mode >= 1 && mode <= 3) Ra = (((16 * (cs_ & ((16 >> lg) - 1)) + 4 * hi_ + m_)) << lg) + (cs_ >> (4 - lg));
            else if (mode == 4) Ra = 16 * fr_ + 4 * wr_ + m_;
            else if (mode == 5) Ra = 64 * wr_ + 4 * fr_ + m_;
            v[i] = (unsigned)(Ra * lda + C) * 2u; }
        hs = (mode >= 1 && mode <= 3) ? (size_t)(8 << lg) * lda * 2 : (mode == 4 ? (size_t)8 * lda * 2 : (size_t)HALF * lda * 2); };
    const unsigned ldsw = (unsigned)wid * 1024u;
    const int aoff = lds_byte(wr * 64 + fr, fq * 8), boff = lds_byte(wc * 32 + fr, fq * 8);
#define PG8_SA(b, h) (((b) * 2 + (h)) * HTB)
#define PG8_SB(b, h) ((4 + (b) * 2 + (h)) * HTB)
#define PG8_STAGE(bufoff, gbase, voff) do { _Pragma("unroll") for (int _i = 0; _i < 2; ++_i) \
        __builtin_amdgcn_global_load_lds((const unsigned*)((const char*)(gbase) + (voff)[_i]), (PG8_LAS unsigned*)(lds + (bufoff) + ldsw + _i * 8192), 16, 0, 0); } while (0)
#define PG8_LDA(dst, b, h) do { _Pragma("unroll") for (int m = 0; m < 4; ++m) _Pragma("unroll") for (int k = 0; k < 2; ++k) dst[m][k] = *(const PG8_LAS bf16x8*)(lds + PG8_SA(b, h) + aoff + m * 2048 + k * 1024); } while (0)
#define PG8_LDB(dst, b, h) do { _Pragma("unroll") for (int n = 0; n < 2; ++n) _Pragma("unroll") for (int k = 0; k < 2; ++k) dst[n][k] = *(const PG8_LAS bf16x8*)(lds + PG8_SB(b, h) + boff + n * 2048 + k * 1024); } while (0)
#define PG8_MMA(ai, bj, At, Bt) do { __builtin_amdgcn_s_setprio(1); _Pragma("unroll") for (int m = 0; m < 4; ++m) _Pragma("unroll") for (int n = 0; n < 2; ++n) _Pragma("unroll") for (int k = 0; k < 2; ++k) \
        acc[ai][bj][m][n] = __builtin_amdgcn_mfma_f32_16x16x32_bf16(Bt[n][k], At[m][k], acc[ai][bj][m][n], 0, 0, 0); __builtin_amdgcn_s_setprio(0); } while (0)
#define PG8_WAIT_V(n) asm volatile("s_waitcnt vmcnt(" #n ")" ::: "memory")
#define PG8_WAIT_V8R do { if (relax_) { if constexpr (!(ALIGN_EPI && SP2)) { PG8_WAIT_V(8); } else if constexpr (Epi::VM_MIN >= 40) { PG8_WAIT_V(50); } else if constexpr (Epi::VM_MIN >= 32) { PG8_WAIT_V(42); } else if constexpr (Epi::VM_MIN >= 24) { PG8_WAIT_V(34); } else if constexpr (Epi::VM_MIN >= 16) { PG8_WAIT_V(26); } else if (relax16_) { PG8_WAIT_V(26); } else { PG8_WAIT_V(18); } } else { PG8_WAIT_V(8); } } while (0)
#define PG8_WAIT_L(n) asm volatile("s_waitcnt lgkmcnt(" #n ")" ::: "memory")
#define PG8_BAR __builtin_amdgcn_s_barrier()
#define PG8_SCHED __builtin_amdgcn_sched_barrier(0)
    Unit cur, nxt; int ui = 0, prv_pn = 0;
    if (!S.next(0, cur)) return;
    if constexpr (Epi::AMODES) { set_amode(cur.amode, voffA, hsA); }
    f32x4 acc[2][2][4][2];
#pragma unroll
    for (int a = 0; a < 2; ++a)
#pragma unroll
        for (int b = 0; b < 2; ++b)
#pragma unroll
            for (int m = 0; m < 4; ++m)
#pragma unroll
                for (int n = 0; n < 2; ++n) acc[a][b][m][n] = (f32x4){0.f, 0.f, 0.f, 0.f};
    bf16x8 At[4][2], B0[2][2], B1[2][2];
    const char* cA = (const char*)g.A + (size_t)cur.ar * arow; const char* cB = (const char*)g.Bt + (size_t)cur.br * ldb * 2;
    S.a_ready(cur);
    if constexpr (SP2) {
        PG8_STAGE(PG8_SB(0, 0), cB, voffB); PG8_STAGE(PG8_SB(0, 1), cB + hsB, voffB); PG8_STAGE(PG8_SA(0, 0), cA, voffA); PG8_STAGE(PG8_SA(0, 1), cA + hsA, voffA);
        if (wr == 1) PG8_BAR;
        PG8_WAIT_V(2); PG8_BAR;
        PG8_STAGE(PG8_SB(1, 0), cB + kstep, voffB); PG8_STAGE(PG8_SA(1, 0), cA + kstepA, voffA); PG8_STAGE(PG8_SB(1, 1), cB + hsB + kstep, voffB);
        PG8_WAIT_V(6); PG8_BAR;
    } else {
        PG8_STAGE(PG8_SB(0, 0), cB, voffB); PG8_STAGE(PG8_SA(0, 0), cA, voffA); PG8_STAGE(PG8_SB(0, 1), cB + hsB, voffB); PG8_STAGE(PG8_SA(0, 1), cA + hsA, voffA);
        if (wr == 1) PG8_BAR;
        PG8_WAIT_V(4); PG8_BAR;
        PG8_STAGE(PG8_SB(1, 0), cB + kstep, voffB); PG8_STAGE(PG8_SA(1, 0), cA + kstepA, voffA); PG8_STAGE(PG8_SB(1, 1), cB + hsB + kstep, voffB);
        PG8_WAIT_V(6); PG8_BAR;
    }
    for (;;) {
        const bool has_next = S.next(ui + 1, nxt);
        if constexpr (Epi::AMODES) { set_amode(has_next ? nxt.amode : cur.amode, voffAn, hsAn); }
        const char* nA = has_next ? (const char*)g.A + (size_t)nxt.ar * arow : cA; const char* nB = has_next ? (const char*)g.Bt + (size_t)nxt.br * ldb * 2 : cB;
        for (int t = 0; t < nt; t += 2) {
            const bool last = (t == nt - 2);
            const char* a1 = cA + (size_t)(t + 1) * kstepA;
            const char* a2 = last ? nA : cA + (size_t)(t + 2) * kstepA; const char* b2 = last ? nB : cB + (size_t)(t + 2) * kstep;
            const char* a3 = a2 + kstepA; const char* b3 = b2 + kstep;
            if (last && has_next) S.a_ready(nxt);
            unsigned vA2_[2]; size_t hsA2;
            if constexpr (Epi::AMODES) { vA2_[0] = last ? voffAn[0] : voffA[0]; vA2_[1] = last ? voffAn[1] : voffA[1]; hsA2 = last ? hsAn : hsA; } else { vA2_[0] = voffA[0]; vA2_[1] = voffA[1]; hsA2 = hsA; }
            const bool relax_ = __builtin_amdgcn_readfirstlane((int)(Epi::VM_MIN >= 8 && t == 0 && ui > 0)) != 0;
            const bool relax16_ = __builtin_amdgcn_readfirstlane((int)(Epi::AMODES && t == 0 && ui > 0 && prv_pn < 20)) != 0;
            if constexpr (SP2) {
            PG8_LDB(B0, 0, 0); PG8_LDB(B1, 0, 1); PG8_SCHED; PG8_LDA(At, 0, 0); PG8_STAGE(PG8_SA(1, 1), a1 + hsA, voffA);
            PG8_WAIT_V8R; PG8_WAIT_L(0); PG8_BAR; PG8_MMA(0, 0, At, B0); PG8_MMA(0, 1, At, B1); PG8_BAR; PG8_SCHED;
            PG8_LDA(At, 0, 1); PG8_STAGE(PG8_SB(0, 0), b2, voffB); PG8_STAGE(PG8_SB(0, 1), b2 + hsB, voffB); PG8_STAGE(PG8_SA(0, 0), a2, vA2_);
            PG8_WAIT_V8R; PG8_WAIT_L(0); PG8_BAR; PG8_MMA(1, 0, At, B0); PG8_MMA(1, 1, At, B1); PG8_BAR; PG8_SCHED;
            PG8_LDB(B0, 1, 0); PG8_LDB(B1, 1, 1); PG8_SCHED; PG8_LDA(At, 1, 0); PG8_STAGE(PG8_SA(0, 1), a2 + hsA2, vA2_);
            PG8_WAIT_V8R; PG8_WAIT_L(0); PG8_BAR; PG8_MMA(0, 0, At, B0); PG8_MMA(0, 1, At, B1); PG8_BAR; PG8_SCHED;
            PG8_LDA(At, 1, 1); PG8_STAGE(PG8_SB(1, 0), b3, voffB); PG8_STAGE(PG8_SB(1, 1), b3 + hsB, voffB); PG8_STAGE(PG8_SA(1, 0), a3, vA2_);
            PG8_WAIT_V(8); PG8_WAIT_L(0); PG8_BAR; PG8_MMA(1, 0, At, B0); PG8_MMA(1, 1, At, B1); PG8_BAR; PG8_SCHED;
            } else {
            PG8_LDB(B0, 0, 0); PG8_SCHED; PG8_LDA(At, 0, 0); PG8_STAGE(PG8_SA(1, 1), a1 + hsA, voffA);
            PG8_WAIT_L(8); PG8_BAR; PG8_WAIT_L(0); PG8_MMA(0, 0, At, B0); PG8_BAR; PG8_SCHED;
            PG8_LDB(B1, 0, 1); PG8_STAGE(PG8_SB(0, 0), b2, voffB);
            PG8_BAR; PG8_WAIT_L(0); PG8_MMA(0, 1, At, B1); PG8_BAR;
            PG8_LDA(At, 0, 1); PG8_STAGE(PG8_SA(0, 0), a2, vA2_);
            PG8_BAR; PG8_WAIT_L(0); PG8_MMA(1, 0, At, B0); PG8_BAR; PG8_SCHED;
            PG8_STAGE(PG8_SB(0, 1), b2 + hsB, voffB);
            PG8_WAIT_V(6); PG8_BAR; PG8_MMA(1, 1, At, B1); PG8_BAR;
            PG8_LDB(B0, 1, 0); PG8_SCHED; PG8_LDA(At, 1, 0); PG8_STAGE(PG8_SA(0, 1), a2 + hsA2, vA2_);
            PG8_WAIT_L(8); PG8_BAR; PG8_WAIT_L(0); PG8_MMA(0, 0, At, B0); PG8_BAR; PG8_SCHED;
            PG8_LDB(B1, 1, 1); PG8_STAGE(PG8_SB(1, 0), b3, voffB);
            PG8_BAR; PG8_WAIT_L(0); PG8_MMA(0, 1, At, B1); PG8_BAR;
            PG8_LDA(At, 1, 1); PG8_STAGE(PG8_SA(1, 0), a3, vA2_);
            PG8_BAR; PG8_WAIT_L(0); PG8_MMA(1, 0, At, B0); PG8_BAR; PG8_SCHED;
            PG8_STAGE(PG8_SB(1, 1), b3 + hsB, voffB);
            PG8_WAIT_V(6); PG8_BAR; PG8_MMA(1, 1, At, B1); PG8_BAR;
            }
        }
        if constexpr (ALIGN_EPI) { if (wr == 0) PG8_BAR; }
        if constexpr (ALIGN_EPI && SP2) {
            if (has_next) { if constexpr (Epi::AMODES) { PG8_STAGE(PG8_SA(1, 1), nA + kstepA + hsAn, voffAn); } else { PG8_STAGE(PG8_SA(1, 1), nA + kstepA + hsA, voffA); } } }
        if constexpr (!Epi::AFTER_DRAIN) { E(acc, cur, wr, wc, fr, fq); S.done(cur); }
        if (!has_next) break;
#pragma unroll
        for (int a = 0; a < 2; ++a)
#pragma unroll
            for (int b = 0; b < 2; ++b)
#pragma unroll
                for (int m = 0; m < 4; ++m)
#pragma unroll
                    for (int n = 0; n < 2; ++n) acc[a][b][m][n] = (f32x4){0.f, 0.f, 0.f, 0.f};
        prv_pn = cur.pn; cur = nxt; cA = nA; cB = nB; ++ui;
        if constexpr (Epi::AMODES) { voffA[0] = voffAn[0]; voffA[1] = voffAn[1]; hsA = hsAn; }
        if constexpr (ALIGN_EPI) { if (wr == 1) PG8_BAR; }
    }
    PG8_WAIT_V(0);
    if constexpr (!ALIGN_EPI) { if (wr == 0) PG8_BAR; }
    PG8_BAR;
    if constexpr (Epi::AFTER_DRAIN) { E.fused(acc, cur, wr, wc, fr, fq, lds, wid, lane); S.done(cur); }
#undef PG8_SA
#undef PG8_SB
#undef PG8_STAGE
#undef PG8_LDA
#undef PG8_LDB
#undef PG8_MMA
#undef PG8_WAIT_V
#undef PG8_WAIT_V8R
#undef PG8_WAIT_L
#undef PG8_BAR
#undef PG8_SCHED
}}

using pg8::Unit;
typedef f32x4 Acc[2][2][4][2];

#ifndef ST_AUX
#define ST_AUX 18
#endif
template <int W> __device__ __forceinline__ size_t blk_idx(int row, int c) { return ((size_t)((row >> 8) * (W / 64) + (c >> 6)) * 256 + (row & 255)) * 64 + (c & 63); }

__device__ __forceinline__ void st16b(bf16_t* base, bf16_t* p, u32x4 v) {
    const __amdgpu_buffer_rsrc_t r = __builtin_amdgcn_make_buffer_rsrc((void*)base, (short)0, 0x7fffffff, 0x00020000);
    __builtin_amdgcn_raw_buffer_store_b128(v, r, (int)((char*)p - (char*)base), 0, ST_AUX);
}
struct EpiInProj {
    static constexpr bool PERM = true, AFTER_DRAIN = false; static constexpr int VM_MIN = 8;
    static constexpr bool AROW4 = false, AMODES = true;
    bf16_t *U2, *Q, *K, *V, *GA, *GB; const float *qg, *kg;
    __device__ __forceinline__ void operator()(Acc& acc, const Unit& u, int wr, int wc, int fr, int fq) const {
        const int pn = u.pn, row0 = u.pm * 256 + wr * 64 + fr;
        if (pn < 2) {
#pragma unroll
            for (int ai = 0; ai < 2; ++ai)
#pragma unroll
                for (int m = 0; m < 4; ++m) { const int row = row0 + ai * 128 + m * 16, b = row >> 11, t = row & 2047, c = t >> 5, i = t & 31;
#pragma unroll
                    for (int bj = 0; bj < 2; ++bj) { const int cl = 256 * pn + 128 * bj + 32 * wc + 8 * fq, g = cl >> 4;
                        bf16_t* dst = U2 + ((size_t)(g * 1024 + b * 64 + c) * U2LD + 128 + i * 16 + (cl & 15));
                        *(u32x4*)dst = pack8(acc[ai][bj][m][0], acc[ai][bj][m][1]);     } }
        } else if (pn < 14) {
            const bool isq = pn < 8; const int head = 4 * (isq ? pn - 2 : pn - 8) + wc, lg = 2 * (head >> 3);
            const float* gs = isq ? qg : kg; bf16_t* base = (isq ? Q : K) + 8 * (32 * (fq & 1)) + 512 * (fq >> 1);
            const float sc = isq ? 0.125f * LOG2E : 1.0f;
            f32x4 gv[2][2];
#pragma unroll
            for (int bj = 0; bj < 2; ++bj)
#pragma unroll
                for (int n = 0; n < 2; ++n) gv[bj][n] = *(const f32x4*)(gs + 32 * bj + 8 * fq + 4 * n) * sc;
#pragma unroll
            for (int ai = 0; ai < 2; ++ai)
#pragma unroll
                for (int m = 0; m < 4; ++m) { float ss = 0.f;
#pragma unroll
                    for (int bj = 0; bj < 2; ++bj)
#pragma unroll
                        for (int n = 0; n < 2; ++n) { const f32x4 x = acc[ai][bj][m][n]; ss += (x[0] * x[0] + x[1] * x[1]) + (x[2] * x[2] + x[3] * x[3]); }
                    ss += __shfl_xor(ss, 16); ss += __shfl_xor(ss, 32);
                    const float rs = __builtin_amdgcn_rsqf(ss * (1.0f / 64.0f) + EPS);
                    const int trow = lg == 0 ? wr * 64 + fr + ai * 128 + m * 16 : (lg == 2 ? 128 * ai + 64 * wr + 4 * fr + m : 16 * fr + 8 * ai + 4 * wr + m);
                    const int row = u.pm * 256 + trow, b = row >> 11, t = row & 2047, tp = ((t & ((1 << lg) - 1)) << (11 - lg)) + (t >> lg);
                    bf16_t* rowp = base + ((size_t)(b * NHEADS + head) * SEQ + (tp & ~31)) * HD + 8 * (tp & 31);
#pragma unroll
                    for (int bj = 0; bj < 2; ++bj) st16b(isq ? Q : K, rowp + 1024 * bj, pack8(acc[ai][bj][m][0] * rs * gv[bj][0], acc[ai][bj][m][1] * rs * gv[bj][1])); }
        } else if (pn < 20) {
            const int lg = 2 * ((pn - 14) >> 1), hi_ = fr & 1, cs = 8 * wr + (fr >> 1), c = cs >> (4 - lg), sg = cs & ((16 >> lg) - 1);
            const int tile_t0 = (u.pm * 256) & 2047, b = (u.pm * 256) >> 11;
            const int rb16 = c * (2048 >> lg) + (tile_t0 >> lg) + 16 * sg;
            const size_t blk = (size_t)(rb16 & ~31) * HD + (size_t)(2 * (wc & 1) + ((rb16 >> 4) & 1)) * 512 + hi_ * 256 + fq * 8;
#pragma unroll
            for (int bj = 0; bj < 2; ++bj) { const int head = 4 * (pn - 14) + 2 * bj + (wc >> 1); bf16_t* hp = V + (size_t)(b * NHEADS + head) * SEQ * HD + blk;
#pragma unroll
                for (int n = 0; n < 2; ++n)
#pragma unroll
                    for (int e = 0; e < 4; ++e) { u32x4 w;
                        w.x = cvt_pk_bf16(acc[0][bj][0][n][e], acc[0][bj][1][n][e]); w.y = cvt_pk_bf16(acc[0][bj][2][n][e], acc[0][bj][3][n][e]);
                        w.z = cvt_pk_bf16(acc[1][bj][0][n][e], acc[1][bj][1][n][e]); w.w = cvt_pk_bf16(acc[1][bj][2][n][e], acc[1][bj][3][n][e]);
                        st16b(V, hp + (4 * n + e) * 32, w); } }
        } else {
            int fq_ = fq; asm volatile("" : "+v"(fq_));
            unsigned char* base = (unsigned char*)(pn < 24 ? GA : GB) + 256 * (pn < 24 ? pn - 20 : pn - 24) + 64 * wc + 16 * fq_;
#pragma unroll
            for (int ai = 0; ai < 2; ++ai)
#pragma unroll
                for (int m = 0; m < 4; ++m) { unsigned char* rowp = base + (size_t)(row0 + ai * 128 + m * 16) * DM; u32x4 w;
                    w.x = gate4_u8(acc[ai][0][m][0]); w.y = gate4_u8(acc[ai][0][m][1]); w.z = gate4_u8(acc[ai][1][m][0]); w.w = gate4_u8(acc[ai][1][m][1]);
                    st16b(pn < 24 ? GA : GB, (bf16_t*)rowp, w); __builtin_amdgcn_sched_barrier(0); }
        }
    }
};

struct EpiSsmState {
    static constexpr bool PERM = false, AFTER_DRAIN = true; static constexpr int VM_MIN = 0; static constexpr bool AROW4 = false, AMODES = false;
    bf16_t* U2; const f32x2* APOW;
    __device__ __forceinline__ void fused(Acc& acc, const Unit& u, int wr, int wc, int fr, int fq, LAS unsigned char* lds, int wid, int lane) const {
        LAS float* Z = (LAS float*)lds;
#pragma unroll
        for (int ai = 0; ai < 2; ++ai)
#pragma unroll
            for (int m = 0; m < 4; ++m)
#pragma unroll
                for (int n = 0; n < 2; ++n) *(LAS f32x4*)(Z + (ai * 128 + wr * 64 + m * 16 + fr) * ZS + 32 * wc + 16 * n + 4 * fq) = acc[ai][0][m][n];
        asm volatile("s_waitcnt lgkmcnt(0)" ::: "memory"); __builtin_amdgcn_s_barrier(); asm volatile("" ::: "memory");
        const int tid = wid * 64 + lane;
        if (tid < 256) {
            const int bl = tid >> 6, p = tid & 63, g = u.pm >> 2;
            const f32x2 a = APOW[g * 64 + p]; float sr = 0.f, si = 0.f;
            bf16_t* dst = U2 + (size_t)(u.pm * 256 + bl * 64) * U2LD + p; const LAS float* zp = Z + (bl * 64) * ZS + p;
            float zr[NCH], zi[NCH];
#pragma unroll
            for (int c = 0; c < NCH; ++c) { zr[c] = zp[c * ZS]; zi[c] = zp[c * ZS + 64]; }
#pragma unroll
            for (int c = 0; c < NCH; ++c) {
                dst[(size_t)c * U2LD] = (bf16_t)f2bf(sr); dst[(size_t)c * U2LD + 64] = (bf16_t)f2bf(si);
                const float nr = a.x * sr - a.y * si + zr[c], ni = a.x * si + a.y * sr + zi[c]; sr = nr; si = ni;
            }
        }
        asm volatile("s_waitcnt lgkmcnt(0)" ::: "memory"); __builtin_amdgcn_s_barrier(); asm volatile("" ::: "memory");
    }
};

struct EpiSsmOut {
    static constexpr bool PERM = true, AFTER_DRAIN = false; static constexpr int VM_MIN = 16; static constexpr bool AROW4 = false, AMODES = false;
    bf16_t* Y;
    __device__ __forceinline__ void operator()(Acc& acc, const Unit& u, int wr, int wc, int fr, int fq) const {
        const int g = u.pm >> 2;
#pragma unroll
        for (int ai = 0; ai < 2; ++ai) {
#pragma unroll
            for (int bj = 0; bj < 2; ++bj) { const int n0 = 256 * u.pn + 128 * bj + 32 * wc + 8 * fq, i = n0 >> 4, co0 = n0 & 15;
#pragma unroll
                for (int m = 0; m < 4; ++m) { const int rl = 256 * (u.pm & 3) + 128 * ai + 64 * wr + 16 * m + fr, b = rl >> 6, c = rl & 63;
                    const f32x4 y0 = gelu4(acc[ai][bj][m][0]), y1 = gelu4(acc[ai][bj][m][1]);
                    *(u32x4*)(Y + blk_idx<SSMW>(b * SEQ + c * CT + i, g * 16 + co0)) = pack8(y0, y1); } } }
    }
};

struct EpiUp {
    static constexpr bool PERM = true, AFTER_DRAIN = false; static constexpr int VM_MIN = 24; static constexpr bool AROW4 = false, AMODES = false;
    const bf16_t* GB; bf16_t* T;
    __device__ __forceinline__ void operator()(Acc& acc, const Unit& u, int wr, int wc, int fr, int fq) const {
        const size_t off0 = (size_t)(u.pm * 256 + wr * 64 + fr) * DM + 256 * u.pn + 32 * wc + 8 * fq;
        const unsigned char* gbase = (const unsigned char*)GB + (size_t)(u.pm * 256 + wr * 64 + fr) * DM + 256 * u.pn + 64 * wc + 16 * fq;
#pragma unroll
        for (int ai = 0; ai < 2; ++ai) { u32x4 gq[4];
#pragma unroll
            for (int m = 0; m < 4; ++m) gq[m] = *(const u32x4*)(gbase + (size_t)(ai * 128 + m * 16) * DM);
            __builtin_amdgcn_sched_barrier(0);
#pragma unroll
            for (int m = 0; m < 4; ++m)
#pragma unroll
                for (int bj = 0; bj < 2; ++bj) { const f32x4 ga = gate4_f32(bj == 0 ? gq[m].x : gq[m].z), gb = gate4_f32(bj == 0 ? gq[m].y : gq[m].w);
                    *(u32x4*)(T + off0 + (size_t)(ai * 128 + m * 16) * DM + 128 * bj) = pack8(acc[ai][bj][m][0] * ga, acc[ai][bj][m][1] * gb); } }
    }
};

struct EpiGlu {
    static constexpr bool PERM = true, AFTER_DRAIN = false; static constexpr int VM_MIN = 24; static constexpr bool AROW4 = false, AMODES = false;
    const bf16_t *GA, *T; bf16_t* MG;
    __device__ __forceinline__ void operator()(Acc& acc, const Unit& u, int wr, int wc, int fr, int fq) const {
        const size_t off0 = (size_t)(u.pm * 256 + wr * 64 + fr) * DM + 128 * u.pn + 32 * wc + 8 * fq;
        const unsigned char* gbase = (const unsigned char*)GA + (size_t)(u.pm * 256 + wr * 64 + fr) * DM + 256 * (u.pn >> 1) + 64 * wc + 16 * fq + 8 * (u.pn & 1);
#pragma unroll
        for (int ai = 0; ai < 2; ++ai) { u32x2 gq[4]; u32x4 tq[4];
#pragma unroll
            for (int m = 0; m < 4; ++m) { gq[m] = *(const u32x2*)(gbase + (size_t)(ai * 128 + m * 16) * DM); tq[m] = *(const u32x4*)(T + off0 + (size_t)(ai * 128 + m * 16) * DM); }
            __builtin_amdgcn_sched_barrier(0);
#pragma unroll
            for (int m = 0; m < 4; ++m) { f32x4 ta, tb; unpack8(tq[m], ta, tb); const f32x4 ga = gate4_f32(gq[m].x), gb = gate4_f32(gq[m].y);
                f32x4 va = acc[ai][0][m][0], vb = acc[ai][0][m][1]; const f32x4 sa = acc[ai][1][m][0], sb = acc[ai][1][m][1];
#pragma unroll
                for (int e = 0; e < 4; ++e) { va[e] = ga[e] * va[e] * sigmoidp_(sa[e]) + ta[e]; vb[e] = gb[e] * vb[e] * sigmoidp_(sb[e]) + tb[e]; }
                *(u32x4*)(MG + blk_idx<DM>(u.pm * 256 + wr * 64 + fr + ai * 128 + m * 16, 128 * u.pn + 32 * wc + 8 * fq)) = pack8(va, vb); } }
    }
};

struct EpiOut {
    static constexpr bool PERM = true, AFTER_DRAIN = false; static constexpr int VM_MIN = 40; static constexpr bool AROW4 = false, AMODES = false;
    const bf16_t* XN; const float* RINV; bf16_t* X1B; float* SS;
    __device__ __forceinline__ void operator()(Acc& acc, const Unit& u, int wr, int wc, int fr, int fq) const {
        const size_t off0 = (size_t)(u.pm * 256 + wr * 64 + fr) * DM + 256 * u.pn + 32 * wc + 8 * fq;
#pragma unroll
        for (int ai = 0; ai < 2; ++ai) { u32x4 xq[4][2]; float ri[4];
#pragma unroll
            for (int m = 0; m < 4; ++m) { ri[m] = RINV[u.pm * 256 + ai * 128 + wr * 64 + m * 16 + fr];
#pragma unroll
                for (int bj = 0; bj < 2; ++bj) xq[m][bj] = *(const u32x4*)(XN + off0 + (size_t)(ai * 128 + m * 16) * DM + 128 * bj); }
            __builtin_amdgcn_sched_barrier(0);
#pragma unroll
            for (int m = 0; m < 4; ++m) { const int row = u.pm * 256 + ai * 128 + wr * 64 + m * 16 + fr; const size_t off = off0 + (size_t)(ai * 128 + m * 16) * DM; float ss = 0.f;
#pragma unroll
                for (int bj = 0; bj < 2; ++bj) { f32x4 xa, xb; unpack8(xq[m][bj], xa, xb); const f32x4 a = acc[ai][bj][m][0] + xa * ri[m], b = acc[ai][bj][m][1] + xb * ri[m];
                    *(u32x4*)(X1B + off + 128 * bj) = pack8(a, b);
                    ss += (a[0] * a[0] + a[1] * a[1]) + (a[2] * a[2] + a[3] * a[3]) + (b[0] * b[0] + b[1] * b[1]) + (b[2] * b[2] + b[3] * b[3]); }
                ss += __shfl_xor(ss, 16); ss += __shfl_xor(ss, 32);
                if (fq == 0) atomicAdd(SS + row, ss); } }
    }
};

__device__ __forceinline__ float dpp_shr1(float old, float src) { return __int_as_float(__builtin_amdgcn_update_dpp(__float_as_int(old), __float_as_int(src), 0x111, 0xF, 0xF, false)); }
__device__ __forceinline__ float dpp_shr2(float old, float src) { return __int_as_float(__builtin_amdgcn_update_dpp(__float_as_int(old), __float_as_int(src), 0x112, 0xF, 0xF, false)); }

__device__ __forceinline__ size_t h_idx(int row, int f) { return ((size_t)((row >> 8) * (DFF / 64) + (f >> 6)) * 256 + (row & 255)) * 64 + (f & 63); }

struct EpiFfn {
    static constexpr bool PERM = true, AFTER_DRAIN = false; static constexpr int VM_MIN = 16; static constexpr bool AROW4 = true, AMODES = false;
    const float *SS, *cw, *cb; bf16_t* H; float *TAIL, *HEADG, *HEADU; LAS float* halo;
    __device__ __forceinline__ void operator()(Acc& acc, const Unit& u, int wr, int wc, int fr, int fq) const {
        const int f0 = 128 * u.pn + 32 * wc + 8 * fq, rowb = u.pm * 256 + wr * 64 + 4 * fr;
        f32x4 w0[2], w1[2], w2[2], bv[2];
#pragma unroll
        for (int n = 0; n < 2; ++n) { w0[n] = *(const f32x4*)(cw + f0 + 4 * n); w1[n] = *(const f32x4*)(cw + DFF + f0 + 4 * n); w2[n] = *(const f32x4*)(cw + 2 * DFF + f0 + 4 * n); bv[n] = *(const f32x4*)(cb + f0 + 4 * n); }
#pragma unroll
        for (int ai = 0; ai < 2; ++ai) { const f32x4 ssv = *(const f32x4*)(SS + rowb + ai * 128);
#pragma unroll
            for (int m = 0; m < 4; ++m) { const float rs = __builtin_amdgcn_rsqf(ssv[m] * (1.0f / DM) + EPS);
#pragma unroll
                for (int bj = 0; bj < 2; ++bj)
#pragma unroll
                    for (int n = 0; n < 2; ++n) acc[ai][bj][m][n] *= rs; } }
        if (fr == 15) {
#pragma unroll
            for (int ai = 0; ai < 2; ++ai)
#pragma unroll
                for (int ms = 0; ms < 2; ++ms)
#pragma unroll
                    for (int n = 0; n < 2; ++n) *(LAS f32x4*)(halo + ((((2 * ai + wr) * 4 + wc) * 2 + ms) * 4 + fq) * 8 + 4 * n) = acc[ai][0][2 + ms][n];
            if (wr == 1) {
#pragma unroll
                for (int ms = 0; ms < 2; ++ms)
#pragma unroll
                    for (int n = 0; n < 2; ++n) *(f32x4*)(TAIL + ((size_t)u.pm * 2 + ms) * DFF + f0 + 4 * n) = acc[1][0][2 + ms][n]; }
        }
        if (fr == 0 && wr == 0) {
#pragma unroll
            for (int ms = 0; ms < 2; ++ms)
#pragma unroll
                for (int n = 0; n < 2; ++n) { *(f32x4*)(HEADG + ((size_t)u.pm * 2 + ms) * DFF + f0 + 4 * n) = acc[0][0][ms][n]; *(f32x4*)(HEADU + ((size_t)u.pm * 2 + ms) * DFF + f0 + 4 * n) = acc[0][1][ms][n]; } }
        asm volatile("s_waitcnt lgkmcnt(0)" ::: "memory"); __builtin_amdgcn_s_barrier(); asm volatile("" ::: "memory");
#pragma unroll
        for (int ai = 0; ai < 2; ++ai) { const int idx = 2 * ai + wr;
            f32x4 tm1[2], tm2[2];
#pragma unroll
            for (int n = 0; n < 2; ++n) { f32x4 h1, h2;
                if (idx > 0) { h1 = *(const LAS f32x4*)(halo + ((((idx - 1) * 4 + wc) * 2 + 1) * 4 + fq) * 8 + 4 * n); h2 = *(const LAS f32x4*)(halo + ((((idx - 1) * 4 + wc) * 2 + 0) * 4 + fq) * 8 + 4 * n); }
                else { h1 = (f32x4){0.f, 0.f, 0.f, 0.f}; h2 = h1; }
#pragma unroll
                for (int e = 0; e < 4; ++e) { tm1[n][e] = dpp_shr1(h1[e], acc[ai][0][3][n][e]); tm2[n][e] = dpp_shr1(h2[e], acc[ai][0][2][n][e]); } }
#pragma unroll
            for (int m = 0; m < 4; ++m) { f32x4 hv[2];
#pragma unroll
                for (int n = 0; n < 2; ++n) { const f32x4 cur = acc[ai][0][m][n];
                    const f32x4 p1 = m == 0 ? tm1[n] : acc[ai][0][m - 1][n], p2 = m == 0 ? tm2[n] : (m == 1 ? tm1[n] : acc[ai][0][m - 2][n]);
                    const f32x4 gp = w2[n] * cur + w1[n] * p1 + w0[n] * p2 + bv[n];
                    hv[n] = gelu4(gp) * acc[ai][1][m][n]; }
                st16b(H, H + h_idx(rowb, f0) + (ai * 128 + m) * 64, pack8(hv[0], hv[1])); } }
    }
};

struct EpiDown {
    static constexpr bool PERM = true, AFTER_DRAIN = false; static constexpr int VM_MIN = 40; static constexpr bool AROW4 = false, AMODES = false;
    const bf16_t* X1B; float* OUT;
    __device__ __forceinline__ void operator()(Acc& acc, const Unit& u, int wr, int wc, int fr, int fq) const {
        const size_t off0 = (size_t)(u.pm * 256 + wr * 64 + fr) * DM + 256 * u.pn + 32 * wc + 8 * fq;
#pragma unroll
        for (int ai = 0; ai < 2; ++ai) { u32x4 xq[4][2];
#pragma unroll
            for (int m = 0; m < 4; ++m)
#pragma unroll
                for (int bj = 0; bj < 2; ++bj) xq[m][bj] = *(const u32x4*)(X1B + off0 + (size_t)(ai * 128 + m * 16) * DM + 128 * bj);
            __builtin_amdgcn_sched_barrier(0);
#pragma unroll
            for (int m = 0; m < 4; ++m)
#pragma unroll
                for (int bj = 0; bj < 2; ++bj) { float* p = OUT + off0 + (size_t)(ai * 128 + m * 16) * DM + 128 * bj; f32x4 xa, xb; unpack8(xq[m][bj], xa, xb);
                    *(f32x4*)p = acc[ai][bj][m][0] + xa; *(f32x4*)(p + 4) = acc[ai][bj][m][1] + xb; } }
    }
};

__device__ __forceinline__ void p0_transpose_item(const float* W0, const float* W1, int ldw, int K, int Nphys, bf16_t* WT, const float* kscale, int mode, LAS float* scr, int item, int lane, float gmul = 1.0f) {
    const int nblk = Nphys / 32, kb = item / nblk, nb = item % nblk, k0 = 64 * kb, n0 = 32 * nb;
    const float* W = W0; int c0 = n0;
    float cm = 1.0f;
    if (mode == 1) { const int pn = n0 >> 8, p = n0 & 255; if (pn >= 2 && pn < 14) c0 = 256 * pn + 64 * ((p >> 5) & 3) + 32 * (p >> 7); if (pn >= 20) cm = gmul; }
    else if (mode == 2) { const int pn = n0 >> 8, p = n0 & 255; W = (p < 128) ? W0 : W1; c0 = 128 * pn + (p & 127); if (p >= 128) cm = gmul; }
    float wv[32];
#pragma unroll
    for (int i = 0; i < 32; ++i) wv[i] = W[(size_t)(k0 + 2 * i + (lane >> 5)) * ldw + c0 + (lane & 31)];
    if (kscale) {
#pragma unroll
        for (int i = 0; i < 32; ++i) wv[i] *= kscale[k0 + 2 * i + (lane >> 5)]; }
#pragma unroll
    for (int i = 0; i < 32; ++i) wv[i] *= cm;
#pragma unroll
    for (int i = 0; i < 32; ++i) scr[(2 * i + (lane >> 5)) * 33 + (lane & 31)] = wv[i];
    asm volatile("s_waitcnt lgkmcnt(0)" ::: "memory");
    const int c = lane & 7;
#pragma unroll
    for (int j = 0; j < 4; ++j) { const int n = (lane >> 3) + 8 * j; const LAS float* s = scr + (8 * c) * 33 + n;
        u32x4 o; o.x = cvt_pk_bf16(s[0 * 33], s[1 * 33]); o.y = cvt_pk_bf16(s[2 * 33], s[3 * 33]); o.z = cvt_pk_bf16(s[4 * 33], s[5 * 33]); o.w = cvt_pk_bf16(s[6 * 33], s[7 * 33]);
        *(u32x4*)(WT + (size_t)(n0 + n) * K + k0 + 8 * c) = o; }
    asm volatile("s_waitcnt lgkmcnt(0)" ::: "memory");
}

__device__ __forceinline__ double d_exp(double x) {
    const double n = __builtin_rint(x * 1.4426950408889634), r = __builtin_fma(-n, 1.9082149292705877e-10, __builtin_fma(-n, 0.6931471803691238, x));
    double p = 1.0 / 6227020800.0;
    p = __builtin_fma(p, r, 1.0 / 479001600.0); p = __builtin_fma(p, r, 1.0 / 39916800.0); p = __builtin_fma(p, r, 1.0 / 3628800.0); p = __builtin_fma(p, r, 1.0 / 362880.0);
    p = __builtin_fma(p, r, 1.0 / 40320.0); p = __builtin_fma(p, r, 1.0 / 5040.0); p = __builtin_fma(p, r, 1.0 / 720.0); p = __builtin_fma(p, r, 1.0 / 120.0);
    p = __builtin_fma(p, r, 1.0 / 24.0); p = __builtin_fma(p, r, 1.0 / 6.0); p = __builtin_fma(p, r, 0.5); p = __builtin_fma(p, r, 1.0); p = __builtin_fma(p, r, 1.0);
    const long long e = (long long)n + 1023; const double sc = __builtin_bit_cast(double, (unsigned long long)e << 52);
    return p * sc;
}
__device__ __forceinline__ void d_sincos(double x, double& s, double& c) {
    const double k = __builtin_rint(x * 0.6366197723675814); double r = __builtin_fma(-k, 1.5707963267948966, x); r = __builtin_fma(-k, 6.123233995736766e-17, r);
    const double r2 = r * r;
    double ps = -1.0 / 1307674368000.0; ps = __builtin_fma(ps, r2, 1.0 / 6227020800.0); ps = __builtin_fma(ps, r2, -1.0 / 39916800.0); ps = __builtin_fma(ps, r2, 1.0 / 362880.0);
    ps = __builtin_fma(ps, r2, -1.0 / 5040.0); ps = __builtin_fma(ps, r2, 1.0 / 120.0); ps = __builtin_fma(ps, r2, -1.0 / 6.0); ps = __builtin_fma(ps * r2, r, r);
    double pc = 1.0 / 20922789888000.0; pc = __builtin_fma(pc, r2, -1.0 / 87178291200.0); pc = __builtin_fma(pc, r2, 1.0 / 479001600.0); pc = __builtin_fma(pc, r2, -1.0 / 3628800.0);
    pc = __builtin_fma(pc, r2, 1.0 / 40320.0); pc = __builtin_fma(pc, r2, -1.0 / 720.0); pc = __builtin_fma(pc, r2, 1.0 / 24.0); pc = __builtin_fma(pc, r2, -0.5); pc = __builtin_fma(pc, r2, 1.0);
    const int q = (int)((long long)k & 3);
    s = (q == 0) ? ps : (q == 1) ? pc : (q == 2) ? -ps : -pc;
    c = (q == 0) ? pc : (q == 1) ? -ps : (q == 2) ? -pc : ps;
}
__device__ __forceinline__ void ssm_pow(const float* lam_re, const float* lam_im, const float* log_dt, int g, int p, int tau, bool times_coef, float& ore, float& oim) {
    const double dt = d_exp((double)log_dt[g]), lr = (double)lam_re[g * 64 + p], li = (double)lam_im[g * 64 + p];
    double s, c; d_sincos(li * dt * tau, s, c); const double mag = d_exp(lr * dt * tau); double wr = mag * c, wi = mag * s;
    if (times_coef) { double s1, c1; d_sincos(li * dt, s1, c1); const double m1 = d_exp(lr * dt), ar = m1 * c1, ai = m1 * s1, den = lr * lr + li * li;
        const double cr = ((ar - 1.0) * lr + ai * li) / den, ci = (ai * lr - (ar - 1.0) * li) / den; const double tr = wr * cr - wi * ci, ti = wr * ci + wi * cr; wr = tr; wi = ti; }
    ore = (float)wr; oim = (float)wi;
}
__device__ __forceinline__ void p0_toeplitz(const float* lam_re, const float* lam_im, const float* log_dt, const float* b_re, const float* b_im, const float* c_re, const float* c_im, const float* Dskip, bf16_t* TM, int g, int tau, int lane) {
    float wre, wim; ssm_pow(lam_re, lam_im, log_dt, g, lane, tau, true, wre, wim);
    const int co = lane >> 2, cq = lane & 3; float o0 = 0.f, o1 = 0.f, o2 = 0.f, o3 = 0.f;
    for (int p = 0; p < 64; ++p) { const float wr = __shfl(wre, p), wi = __shfl(wim, p);
        const float cr = c_re[(g * 16 + co) * 64 + p], ci = c_im[(g * 16 + co) * 64 + p]; const float xr = cr * wr - ci * wi, xi = cr * wi + ci * wr;
        const f32x4 br = *(const f32x4*)(b_re + (g * 64 + p) * 16 + 4 * cq), bi = *(const f32x4*)(b_im + (g * 64 + p) * 16 + 4 * cq);
        o0 += xr * br[0] - xi * bi[0]; o1 += xr * br[1] - xi * bi[1]; o2 += xr * br[2] - xi * bi[2]; o3 += xr * br[3] - xi * bi[3]; }
    if (tau == 0 && cq == (co >> 2)) { const float dv = Dskip[g * 16 + co]; const int k = co & 3;
        o0 += k == 0 ? dv : 0.f; o1 += k == 1 ? dv : 0.f; o2 += k == 2 ? dv : 0.f; o3 += k == 3 ? dv : 0.f; }
    u32x2 w; w.x = cvt_pk_bf16(o0, o1); w.y = cvt_pk_bf16(o2, o3); const u32x2 z = (u32x2){0u, 0u};
    bf16_t* base = TM + (size_t)g * 512 * U2LD + 128 + 4 * cq;
    for (int i = tau; i < CT; ++i) *(u32x2*)(base + (size_t)(16 * i + co) * U2LD + 16 * (i - tau)) = w;
    if (tau > 0) for (int i = 0; i + tau < CT; ++i) *(u32x2*)(base + (size_t)(16 * i + co) * U2LD + 16 * (i + tau)) = z;
}
__device__ __forceinline__ void p0_tstate(const float* lam_re, const float* lam_im, const float* log_dt, const float* c_re, const float* c_im, bf16_t* TM, int g, int i, int lane) {
    float er, ei; ssm_pow(lam_re, lam_im, log_dt, g, lane, i + 1, false, er, ei);
    for (int co = 0; co < 16; ++co) { const float cr = c_re[(g * 16 + co) * 64 + lane], ci = c_im[(g * 16 + co) * 64 + lane];
        bf16_t* row = TM + ((size_t)g * 512 + 16 * i + co) * U2LD; row[lane] = (bf16_t)f2bf(cr * er - ci * ei); row[64 + lane] = (bf16_t)f2bf(-(cr * ei + ci * er)); }
}
__device__ __forceinline__ void p0_hmat(const float* lam_re, const float* lam_im, const float* log_dt, const float* b_re, const float* b_im, bf16_t* HM, int g, int i, int lane) {
    float wr, wi; ssm_pow(lam_re, lam_im, log_dt, g, lane, CT - 1 - i, true, wr, wi);
    f32x4 br[4], bi[4];
#pragma unroll
    for (int j = 0; j < 4; ++j) { br[j] = *(const f32x4*)(b_re + (g * 64 + lane) * 16 + 4 * j); bi[j] = *(const f32x4*)(b_im + (g * 64 + lane) * 16 + 4 * j); }
    bf16_t* r0 = HM + ((size_t)g * 128 + lane) * 512 + 16 * i; bf16_t* r1 = r0 + (size_t)64 * 512;
    *(u32x4*)r0 = pack8(br[0] * wr - bi[0] * wi, br[1] * wr - bi[1] * wi); *(u32x4*)(r0 + 8) = pack8(br[2] * wr - bi[2] * wi, br[3] * wr - bi[3] * wi);
    *(u32x4*)r1 = pack8(br[0] * wi + bi[0] * wr, br[1] * wi + bi[1] * wr); *(u32x4*)(r1 + 8) = pack8(br[2] * wi + bi[2] * wr, br[3] * wi + bi[3] * wr);
}

__device__ __forceinline__ int crow(int r, int hi) { return (r & 3) + 8 * (r >> 2) + 4 * hi; }
struct AttTile { size_t hb; int rb, j0, tl0, dil, kt0, mode, b, hh, quarter; float slope2; };
__device__ __forceinline__ AttTile att_tile_params(int t, int wid, int vcu, int bx, int G) {
    AttTile P; const int ui = t / 6, rnd = (t % 6) >> 1, w = wid + 8 * (t & 1);
    int pair, quarter;
    if (G == 256) { pair = bx & 127; quarter = (bx >= 128) ? (ui == 0 ? 1 : 2) : (ui == 0 ? 3 : 0); }
    else { const int un = bx + ui * G; pair = un >> 2; quarter = un & 3; }
    P.b = pair >> 3; P.hh = pair & 7; P.quarter = quarter; P.mode = rnd;
    const int g = 2 - rnd;
    P.dil = rnd == 0 ? 16 : (rnd == 1 ? 4 : 1);
    if (rnd == 0) { P.rb = 128 * w; P.j0 = 32 * quarter; P.tl0 = w; }
    else if (rnd == 1) { const int r = w & 3, jb = w >> 2; P.rb = 512 * r; P.j0 = 128 * quarter + 32 * jb; P.tl0 = 128 * jb + r; }
    else { P.rb = 0; P.j0 = 512 * quarter + 32 * w; P.tl0 = 32 * w; }
    P.hb = (size_t)(P.b * NHEADS + 8 * g + P.hh) * SEQ * HD;
    P.kt0 = (P.j0 >= 128) ? 0 : 4 - (P.j0 >> 5);
    P.slope2 = __builtin_amdgcn_exp2f(-(float)(3 * P.hh + g + 1) * (1.0f / 3.0f)) * (float)P.dil * LOG2E;
    return P;
}
__device__ __forceinline__ void attn_phase(const bf16_t* Qb, const bf16_t* Kb, const bf16_t* Vb, bf16_t* OATT, LAS unsigned char* lds, float m0, int ntiles, int wid, int lane, int vcu, int bx, int G) {
    LAS unsigned char* nums = lds; LAS float* dens = (LAS float*)(lds + 65536); LAS unsigned char* vb = lds + 67584 + wid * VT_BYTES;
    const int q = lane & 31, hi = lane >> 5;
    const int vlo = hi * 256 + ((q & 7) * 4 + (q >> 3)) * 8;
    AttTile P = att_tile_params(0, wid, vcu, bx, G);
    bf16x8 qf[4], qn[4], kf[4]; u32x4 vv[4];
#define ATT_LOADQ(QF, PP) do { const bf16_t* qp_ = Qb + (PP).hb + (size_t)((PP).rb + (PP).j0) * HD + lane * 8; \
        _Pragma("unroll") for (int ks = 0; ks < 4; ++ks) QF[ks] = *(const bf16x8*)(qp_ + ks * 512); } while (0)
#define ATT_LOADKV(PP, KT) do { const int k0_ = (PP).j0 - 128 + 32 * (KT); const bf16_t* kp_ = Kb + (PP).hb + (size_t)((PP).rb + k0_) * HD + lane * 8; \
        _Pragma("unroll") for (int ks = 0; ks < 4; ++ks) kf[ks] = *(const bf16x8*)(kp_ + ks * 512); \
        const bf16_t* vp_ = Vb + (PP).hb + (size_t)((PP).rb + k0_) * HD + vlo; \
        _Pragma("unroll") for (int c = 0; c < 4; ++c) vv[c] = *(const u32x4*)(vp_ + c * 512); } while (0)
    ATT_LOADQ(qf, P); ATT_LOADKV(P, P.kt0);
#pragma unroll 1
    for (int t = 0; t < ntiles; ++t) {
        const AttTile Pn = att_tile_params(t + 1 < ntiles ? t + 1 : t, wid, vcu, bx, G);
        if (t > 0 && (t & 1) == 0) { asm volatile("s_waitcnt lgkmcnt(0)" ::: "memory"); __builtin_amdgcn_s_barrier(); asm volatile("" ::: "memory"); }
        const int tl = P.tl0 + q * P.dil;
        LAS unsigned char* np = nums + tl * 128 + 8 * hi;
        const int nsw = ((tl ^ (tl >> 2) ^ (tl >> 4)) & 7) * 16;
        f32x16 o0 = {}, o1 = {}; float den = 0.f;
        if (P.mode != 0) {
            if (hi == 0) den = dens[tl];
#pragma unroll
            for (int rq = 0; rq < 4; ++rq) { const u32x2 a = *(const LAS u32x2*)(np + ((16 * rq) ^ nsw)), b = *(const LAS u32x2*)(np + ((64 + 16 * rq) ^ nsw));
                o0[4 * rq] = bf_lo(a.x); o0[4 * rq + 1] = bf_hi(a.x); o0[4 * rq + 2] = bf_lo(a.y); o0[4 * rq + 3] = bf_hi(a.y);
                o1[4 * rq] = bf_lo(b.x); o1[4 * rq + 1] = bf_hi(b.x); o1[4 * rq + 2] = bf_lo(b.y); o1[4 * rq + 3] = bf_hi(b.y); }
        }
#pragma unroll 1
        for (int kt = P.kt0; kt <= 4; ++kt) {
            f32x16 s = {};
#pragma unroll
            for (int ks = 0; ks < 4; ++ks) s = __builtin_amdgcn_mfma_f32_32x32x16_bf16(kf[ks], qf[ks], s, 0, 0, 0);
            u32x4 vc[4];
#pragma unroll
            for (int c = 0; c < 4; ++c) vc[c] = vv[c];
            { const bool last = kt == 4; const size_t hbn = last ? Pn.hb : P.hb; const int rown = last ? Pn.rb + Pn.j0 - 128 + 32 * Pn.kt0 : P.rb + P.j0 - 128 + 32 * (kt + 1);
              const bf16_t* kp_ = Kb + hbn + (size_t)rown * HD + lane * 8;
#pragma unroll
              for (int ks = 0; ks < 4; ++ks) kf[ks] = *(const bf16x8*)(kp_ + ks * 512);
              const bf16_t* vp_ = Vb + hbn + (size_t)rown * HD + vlo;
#pragma unroll
              for (int c = 0; c < 4; ++c) vv[c] = *(const u32x4*)(vp_ + c * 512);
              if (last) ATT_LOADQ(qn, Pn); }
            __builtin_amdgcn_sched_barrier(0);
            const int dq = 128 - 32 * kt + q;
            const float base = -P.slope2 * (float)dq - m0;
            float p[16];
#pragma unroll
            for (int rr = 0; rr < 16; ++rr) { const int key = crow(rr, hi); float v = s[rr] + base + P.slope2 * (float)key;
                if (kt == 0) { if (dq - key > 128) v = -__builtin_inff(); }
                if (kt == 4) { if (dq - key < 0) v = -__builtin_inff(); }
                p[rr] = __builtin_amdgcn_exp2f(v); den += p[rr]; }
            u32x4 pw0, pw1;
            pw0.x = cvt_pk_bf16(p[0], p[1]); pw0.y = cvt_pk_bf16(p[2], p[3]); pw0.z = cvt_pk_bf16(p[4], p[5]); pw0.w = cvt_pk_bf16(p[6], p[7]);
            pw1.x = cvt_pk_bf16(p[8], p[9]); pw1.y = cvt_pk_bf16(p[10], p[11]); pw1.z = cvt_pk_bf16(p[12], p[13]); pw1.w = cvt_pk_bf16(p[14], p[15]);
            const bf16x8 pb0 = __builtin_bit_cast(bf16x8, pw0), pb1 = __builtin_bit_cast(bf16x8, pw1);
#pragma unroll
            for (int db = 0; db < 2; ++db)
#pragma unroll
                for (int sk = 0; sk < 2; ++sk) {
                    const bf16x8 vf = __builtin_bit_cast(bf16x8, vc[db * 2 + sk]);
                    if (db == 0) o0 = __builtin_amdgcn_mfma_f32_32x32x16_bf16(vf, sk == 0 ? pb0 : pb1, o0, 0, 0, 0);
                    else         o1 = __builtin_amdgcn_mfma_f32_32x32x16_bf16(vf, sk == 0 ? pb0 : pb1, o1, 0, 0, 0);
                }
        }
        den += __shfl_xor(den, 32);
        if (P.mode != 2) {
            if (hi == 0) dens[tl] = den;
#pragma unroll
            for (int db = 0; db < 2; ++db)
#pragma unroll
                for (int rq = 0; rq < 4; ++rq) { u32x2 w; const f32x16& o = db == 0 ? o0 : o1; w.x = cvt_pk_bf16(o[4 * rq], o[4 * rq + 1]); w.y = cvt_pk_bf16(o[4 * rq + 2], o[4 * rq + 3]); *(LAS u32x2*)(np + ((db * 64 + 16 * rq) ^ nsw)) = w; }
        } else {
            const float inv = __builtin_amdgcn_rcpf(den);
#pragma unroll
            for (int db = 0; db < 2; ++db)
#pragma unroll
                for (int rq = 0; rq < 4; ++rq) { u32x2 w; const f32x16& o = db == 0 ? o0 : o1; w.x = cvt_pk_bf16(o[4 * rq] * inv, o[4 * rq + 1] * inv); w.y = cvt_pk_bf16(o[4 * rq + 2] * inv, o[4 * rq + 3] * inv);
                    *(LAS u32x2*)(vb + q * 128 + db * 64 + 16 * rq + 8 * hi) = w; }
            const int orow = P.b * SEQ + 512 * P.quarter + P.tl0;
#pragma unroll
            for (int c = 0; c < 4; ++c) { const int x = c * 64 + lane, r_ = x >> 3; const u32x4 v = *(const LAS u32x4*)(vb + r_ * 128 + (x & 7) * 16);
                *(u32x4*)(OATT + blk_idx<AOUT>(orow + r_, P.hh * 64 + (x & 7) * 8)) = v; }
        }
#pragma unroll
        for (int ks = 0; ks < 4; ++ks) qf[ks] = qn[ks];
        P = Pn;
    }
#undef ATT_LOADQ
#undef ATT_LOADKV
}

#define XB_TMO      128
#define XB_XCNT(j)  (256  + 64 * (j))
#define XB_XSUB(j)  (1280 + 64 * (j))
#define XB_XGEN(j)  (2304 + 64 * (j))
#define XB_TOP      3328
#define XB_TOPGEN   3392
#define XCD_BAR_WORDS 3456
#define XB_SPIN_CAP (1u << 18)

__device__ __forceinline__ unsigned xb_ld(unsigned* p)              { return __hip_atomic_load(p, __ATOMIC_RELAXED, __HIP_MEMORY_SCOPE_AGENT); }
__device__ __forceinline__ unsigned xb_add(unsigned* p, unsigned v) { return __hip_atomic_fetch_add(p, v, __ATOMIC_RELAXED, __HIP_MEMORY_SCOPE_AGENT); }
__device__ __forceinline__ unsigned xb_xcc_id() { return (unsigned)__builtin_amdgcn_s_getreg((3 << 11) | 20) & 0xFu; }
#define XB_SPIN(cond, bar) do { unsigned _sp = 0; while (cond) { __builtin_amdgcn_s_sleep(1); \
    if ((++_sp & 255u) == 0u) { if (xb_ld(&(bar)[XB_TMO])) break; if (_sp > XB_SPIN_CAP) { atomicAdd(&(bar)[XB_TMO], 1u); break; } } } } while (0)

struct XcdBarrier {
    unsigned* bar; unsigned x;
    volatile LAS unsigned* st;
};

__device__ __forceinline__ XcdBarrier xcd_barrier_post(unsigned* bar, volatile LAS unsigned* st) {
    XcdBarrier b; b.bar = bar; b.x = xb_xcc_id(); b.st = st;
    if (threadIdx.x == 0) (void)xb_add(&bar[XB_XCNT(b.x)], 1u);
    return b;
}
__device__ __forceinline__ void xcd_barrier_complete(unsigned* bar, unsigned x, unsigned& nloc, unsigned& nx) {
    const unsigned G = gridDim.x * gridDim.y * gridDim.z;
    unsigned sum, cnt, mine, sp = 0u;
    for (;;) {
        sum = 0u; cnt = 0u; mine = 0u;
#pragma unroll
        for (unsigned j = 0; j < 16; ++j) { const unsigned c = xb_ld(&bar[XB_XCNT(j)]); sum += c; cnt += (c > 0u) ? 1u : 0u; mine = (j == x) ? c : mine; }
        if (sum == G) break;
        __builtin_amdgcn_s_sleep(1);
        if ((++sp & 255u) == 0u) { if (xb_ld(&bar[XB_TMO])) break; if (sp > XB_SPIN_CAP) { atomicAdd(&bar[XB_TMO], 1u); break; } }
    }
    nloc = mine > 0u ? mine : 1u; nx = cnt > 0u ? cnt : 1u;
}

__device__ __forceinline__ void xcd_barrier(const XcdBarrier& b) {
    asm volatile("s_waitcnt vmcnt(0)" ::: "memory");
    __syncthreads();
    if (threadIdx.x == 0) {
        unsigned* bar = b.bar;
        __builtin_amdgcn_s_waitcnt(0);
        unsigned nloc = b.st[0], nx = b.st[1];
        if (nloc == 0u) { xcd_barrier_complete(bar, b.x, nloc, nx); b.st[0] = nloc; b.st[1] = nx; }
        const unsigned old = xb_add(&bar[XB_XSUB(b.x)], 1u);
        const unsigned gen = old / nloc;
        if (old + 1u == (gen + 1u) * nloc) {
            __builtin_amdgcn_fence(__ATOMIC_RELEASE, "agent");
            asm volatile("s_waitcnt vmcnt(0)" ::: "memory");
            const unsigned og = xb_add(&bar[XB_TOP], 1u);
            const unsigned tg = og / nx;
            if (og + 1u == (tg + 1u) * nx) xb_add(&bar[XB_TOPGEN], 1u);
            else XB_SPIN(xb_ld(&bar[XB_TOPGEN]) == tg, bar);
            __builtin_amdgcn_fence(__ATOMIC_ACQUIRE, "agent");
            xb_add(&bar[XB_XGEN(b.x)], 1u);
            asm volatile("s_waitcnt vmcnt(0)" ::: "memory");
        } else {
            XB_SPIN(xb_ld(&bar[XB_XGEN(b.x)]) == gen, bar);
            __builtin_amdgcn_fence(__ATOMIC_ACQUIRE, "agent");
            asm volatile("s_waitcnt vmcnt(0)" ::: "memory");
        }
    }
    __syncthreads();
}

struct Args {
    const float* in[23]; float* out; unsigned char* ws; int ph_lo, ph_hi;
};
enum { I_X = 0, I_NMG, I_WIN, I_LRE, I_LIM, I_LDT, I_BRE, I_BIM, I_CRE, I_CIM, I_D, I_GLV, I_GLG, I_QG, I_KG, I_WUP, I_WOUT, I_NFG, I_FWG, I_FWU, I_CW, I_CB, I_WDN };
constexpr int NPHASE = 8;
#ifndef MK_COOP
#define MK_COOP 1
#endif

__global__ void __launch_bounds__(512, 2) hybrid_fwd(Args args) {
    extern __shared__ __attribute__((aligned(16))) unsigned char lds_raw[];
    LAS unsigned char* lds = (LAS unsigned char*)lds_raw;
    const int tid = threadIdx.x, lane = tid & 63, wid = __builtin_amdgcn_readfirstlane(tid >> 6);
    const int G = gridDim.x, bx = blockIdx.x, vcu = (G % 8 == 0) ? (bx % 8) * (G / 8) + bx / 8 : bx;
    unsigned char* ws = args.ws; unsigned char* dob = (unsigned char*)args.out;
    const int lo = args.ph_lo, hi = args.ph_hi;
    volatile LAS unsigned* MISC = (volatile LAS unsigned*)(lds + LDS_MISC);
    if (tid < 16) MISC[tid] = 0u;
    __syncthreads();
    XcdBarrier bar; bar.bar = (unsigned*)ws; bar.x = 0; bar.st = nullptr;
#if MK_COOP
    bar = xcd_barrier_post((unsigned*)ws, MISC);
#endif
#define IN(k) (lo <= (k) && (k) < hi)
#if MK_COOP
#define SEAM(k) do { if (IN(k) && IN((k) + 1)) { xcd_barrier(bar); } } while (0)
#else
#define SEAM(k) do { } while (0)
#endif
    bf16_t* const WIN = (bf16_t*)(ws + WS_WIN); bf16_t* const WGLU = (bf16_t*)(ws + WS_WGLU); bf16_t* const WUP = (bf16_t*)(ws + WS_WUP); bf16_t* const WOUT = (bf16_t*)(ws + WS_WOUT);
    bf16_t* const WGU = (bf16_t*)(ws + WS_WGU); bf16_t* const WDN = (bf16_t*)(ws + WS_WDN); bf16_t* const TMAT = (bf16_t*)(ws + WS_TMAT); bf16_t* const HMAT = (bf16_t*)(ws + WS_HMAT);
    float* const SS = (float*)(ws + WS_SS); f32x2* const APOW = (f32x2*)(ws + WS_APOW);
    bf16_t* const GA = (bf16_t*)(ws + WS_GA); bf16_t* const GB = (bf16_t*)(ws + WS_GB);
    bf16_t* const Qb = (bf16_t*)(ws + WS_Q); bf16_t* const Kb = (bf16_t*)(ws + WS_K); bf16_t* const Vb = (bf16_t*)(ws + WS_V);
    bf16_t* const YSSM = (bf16_t*)(ws + WS_YSSM); bf16_t* const TMPB = (bf16_t*)(ws + WS_TMPB); bf16_t* const MERGED = (bf16_t*)(ws + WS_MERGED); bf16_t* const X1B = (bf16_t*)(ws + WS_X1B); bf16_t* const HB = (bf16_t*)(ws + WS_H);
    float* const TAIL = (float*)(ws + WS_TAIL); float* const HEADG = (float*)(ws + WS_HEADG); float* const HEADU = (float*)(ws + WS_HEADU);
    bf16_t* const XN = (bf16_t*)(dob + DO_XN); bf16_t* const U2 = (bf16_t*)(dob + DO_U2); bf16_t* const OATT = (bf16_t*)(ws + WS_GA + 32 * MiB);
    float* const RINV = (float*)(ws + WS_RINV);
    float* const OUT = args.out;

    if (IN(0)) {
        LAS float* scr = (LAS float*)(lds + wid * 16384);
        const bool swv = wid < 5; const int gw = swv ? vcu * 5 + wid : vcu * 3 + (wid - 5), NGW = swv ? G * 5 : G * 3;
        constexpr int XSPLIT = 3 * MTOK / 4;
        constexpr int I_IN = 16 * (NIN / 32), I_GL = 8 * (2048 / 32), I_UP = 8 * (1024 / 32), I_OU = 16 * (1024 / 32), I_GU = 16 * (2 * DFF / 32), I_DN = (DFF / 64) * (1024 / 32);
        constexpr int NW = I_IN + I_GL + I_UP + I_OU + I_GU + I_DN;
        for (int it = swv ? NW : gw; it < NW; it += NGW) {
            int r = it;
            if (r < I_IN) { p0_transpose_item(args.in[I_WIN], nullptr, NIN, DM, NIN, WIN, args.in[I_NMG], 1, scr, r, lane, -LOG2E); continue; } r -= I_IN;
            if (r < I_GL) { p0_transpose_item(args.in[I_GLV], args.in[I_GLG], DM, SSMW, 2048, WGLU, nullptr, 2, scr, r, lane, -LOG2E); continue; } r -= I_GL;
            if (r < I_UP) { p0_transpose_item(args.in[I_WUP], nullptr, DM, AOUT, DM, WUP, nullptr, 0, scr, r, lane); continue; } r -= I_UP;
            if (r < I_OU) { p0_transpose_item(args.in[I_WOUT], nullptr, DM, DM, DM, WOUT, nullptr, 0, scr, r, lane); continue; } r -= I_OU;
            if (r < I_GU) { p0_transpose_item(args.in[I_FWG], args.in[I_FWU], DFF, DM, 2 * DFF, WGU, args.in[I_NFG], 2, scr, r, lane); continue; } r -= I_GU;
            p0_transpose_item(args.in[I_WDN], nullptr, DM, DFF, DM, WDN, nullptr, 0, scr, r, lane);
        }
        for (int it = swv ? gw : 3 * 1024 + 32 + 1; it < 3 * 1024 + 32 + 1; it += NGW) {
            if (it < 1024) p0_toeplitz(args.in[I_LRE], args.in[I_LIM], args.in[I_LDT], args.in[I_BRE], args.in[I_BIM], args.in[I_CRE], args.in[I_CIM], args.in[I_D], TMAT, it >> 5, it & 31, lane);
            else if (it < 2048) p0_tstate(args.in[I_LRE], args.in[I_LIM], args.in[I_LDT], args.in[I_CRE], args.in[I_CIM], TMAT, (it - 1024) >> 5, it & 31, lane);
            else if (it < 3072) p0_hmat(args.in[I_LRE], args.in[I_LIM], args.in[I_LDT], args.in[I_BRE], args.in[I_BIM], HMAT, (it - 2048) >> 5, it & 31, lane);
            else if (it < 3104) { float ar, ai; ssm_pow(args.in[I_LRE], args.in[I_LIM], args.in[I_LDT], it - 3072, lane, CT, false, ar, ai); APOW[(it - 3072) * 64 + lane] = (f32x2){ar, ai}; }
            else { for (int j = lane; j < 128 * 512 / 8; j += 64) *(u32x4*)(HMAT + (size_t)32 * 128 * 512 + (size_t)j * 8) = (u32x4){0u, 0u, 0u, 0u}; }
        }
        for (int j = vcu * 512 + tid; j < MTOK; j += G * 512) SS[j] = 0.f;
        const float* X = args.in[I_X];
        for (int m0 = (swv ? XSPLIT : 0) + gw * 4; m0 < (swv ? MTOK : XSPLIT); m0 += NGW * 4) {
            f32x4 v[4][4]; float s[4];
#pragma unroll
            for (int rr = 0; rr < 4; ++rr) { const f32x4* xr = (const f32x4*)(X + (size_t)(m0 + rr) * DM) + lane;
#pragma unroll
                for (int j = 0; j < 4; ++j) v[rr][j] = xr[64 * j]; }
#pragma unroll
            for (int rr = 0; rr < 4; ++rr) { float a = 0.f;
#pragma unroll
                for (int j = 0; j < 4; ++j) a += (v[rr][j][0] * v[rr][j][0] + v[rr][j][1] * v[rr][j][1]) + (v[rr][j][2] * v[rr][j][2] + v[rr][j][3] * v[rr][j][3]);
                s[rr] = a; }
#pragma unroll
            for (int o = 1; o < 64; o <<= 1) {
#pragma unroll
                for (int rr = 0; rr < 4; ++rr) s[rr] += __shfl_xor(s[rr], o); }
#pragma unroll
            for (int rr = 0; rr < 4; ++rr) { const float rs = __builtin_amdgcn_rsqf(s[rr] * (1.0f / DM) + EPS); u32x2* o = (u32x2*)(XN + (size_t)(m0 + rr) * DM) + lane;
                if (lane == 0) RINV[m0 + rr] = __builtin_sqrtf(s[rr] * (1.0f / DM) + EPS);
#pragma unroll
                for (int j = 0; j < 4; ++j) { u32x2 w; w.x = cvt_pk_bf16(v[rr][j][0] * rs, v[rr][j][1] * rs); w.y = cvt_pk_bf16(v[rr][j][2] * rs, v[rr][j][3] * rs); o[64 * j] = w; } }
        }
        asm volatile("s_waitcnt vmcnt(0) lgkmcnt(0)" ::: "memory"); __syncthreads();
    }
    SEAM(0);

    if (IN(1)) {
        pg8::Gemm g{XN, WIN, DM, DM, DM}; pg8::StaticOrder<0> S; S.init(MTOK / 256, NIN / 256, G, bx);
        S.inproj = true;
        EpiInProj E{U2, Qb, Kb, Vb, GA, GB, args.in[I_QG], args.in[I_KG]};
        pg8::gemm_phase<EpiInProj, pg8::StaticOrder<0>, true, true>(lds, g, S, E);
    }
    SEAM(1);

    if (IN(2)) {
        { pg8::Gemm g{U2 + 128, HMAT, CT * GCH, U2LD, CT * GCH}; pg8::StaticOrder<1> S; S.init(128, 1, G, bx);
          EpiSsmState E{U2, APOW};
          pg8::gemm_phase<EpiSsmState, pg8::StaticOrder<1>, false, true>(lds, g, S, E); }
        __syncthreads();
        const float m0 = 8.0f * LOG2E * wave_max(fabsf(args.in[I_QG][lane])) * wave_max(fabsf(args.in[I_KG][lane]));
        const int nun = (G == 256) ? 2 : (512 - bx + G - 1) / G;
        attn_phase(Qb, Kb, Vb, OATT, lds, m0, 6 * nun, wid, lane, vcu, bx, G);
        asm volatile("s_waitcnt vmcnt(0) lgkmcnt(0)" ::: "memory"); __syncthreads();
    }
    SEAM(2);

    if (IN(3)) {
        { pg8::Gemm g{U2, TMAT, U2LD, U2LD, U2LD}; pg8::StaticOrder<2> S; S.init(128, 2, G, bx);
          EpiSsmOut E{YSSM};
          pg8::gemm_phase<EpiSsmOut, pg8::StaticOrder<2>, true, true>(lds, g, S, E); }
        __syncthreads();
        { pg8::Gemm g{OATT, WUP, AOUT, AOUT, AOUT, 1}; pg8::StaticOrder<0> S; S.init(MTOK / 256, DM / 256, G, bx);
          EpiUp E{GB, TMPB};
          pg8::gemm_phase<EpiUp, pg8::StaticOrder<0>, true, true>(lds, g, S, E); }
    }
    SEAM(3);

    if (IN(4)) {
        pg8::Gemm g{YSSM, WGLU, SSMW, SSMW, SSMW, 1}; pg8::StaticOrder<0> S; S.init(MTOK / 256, 2048 / 256, G, bx);
        EpiGlu E{GA, TMPB, MERGED};
        pg8::gemm_phase<EpiGlu, pg8::StaticOrder<0>, true, true>(lds, g, S, E);
    }
    SEAM(4);

    if (IN(5)) {
        pg8::Gemm g{MERGED, WOUT, DM, DM, DM, 1}; pg8::StaticOrder<0> S; S.init(MTOK / 256, DM / 256, G, bx);
        EpiOut E{XN, RINV, X1B, SS};
        pg8::gemm_phase<EpiOut, pg8::StaticOrder<0>, true, true>(lds, g, S, E);
    }
    SEAM(5);

    if (IN(6)) {
        pg8::Gemm g{X1B, WGU, DM, DM, DM}; pg8::StaticOrder<0> S; S.init(MTOK / 256, 2 * DFF / 256, G, bx);
        EpiFfn E{SS, args.in[I_CW], args.in[I_CB], HB, TAIL, HEADG, HEADU, (LAS float*)(lds + LDS_HALO)};
        pg8::gemm_phase<EpiFfn, pg8::StaticOrder<0>, true, true>(lds, g, S, E);
    }
    SEAM(6);

    if (IN(7)) {
        pg8::Gemm g{HB, WDN, DFF, DFF, DFF, 1}; pg8::StaticOrder<0> S; S.init(MTOK / 256, DM / 256, G, bx);
        { const float* cw = args.in[I_CW]; const float* cb = args.in[I_CB]; pg8::Unit uu;
          for (int i = 0; S.next(i, uu); ++i) { const int pm = uu.pm; if ((pm & 7) == 0) continue;
            for (int f = tid; f < DFF; f += 512) {
                const float g0 = HEADG[((size_t)pm * 2) * DFF + f], g1 = HEADG[((size_t)pm * 2 + 1) * DFF + f], ta = TAIL[((size_t)(pm - 1) * 2) * DFF + f], tb = TAIL[((size_t)(pm - 1) * 2 + 1) * DFF + f];
                const float w0 = cw[f], w1 = cw[DFF + f], w2 = cw[2 * DFF + f], bb = cb[f];
                const f32x2 gl = gelu_pk((f32x2){w2 * g0 + w1 * tb + w0 * ta + bb, w2 * g1 + w1 * g0 + w0 * tb + bb});
                HB[h_idx(pm * 256, f)] = (bf16_t)f2bf(gl.x * HEADU[((size_t)pm * 2) * DFF + f]);
                HB[h_idx(pm * 256 + 1, f)] = (bf16_t)f2bf(gl.y * HEADU[((size_t)pm * 2 + 1) * DFF + f]); } }
          asm volatile("s_waitcnt vmcnt(0)" ::: "memory"); __syncthreads(); }
        EpiDown E{X1B, OUT};
        pg8::gemm_phase<EpiDown, pg8::StaticOrder<0>, true, true>(lds, g, S, E);
    }
#undef IN
#undef SEAM
}

extern "C" void kernel_launch(void* const* d_in, const int* in_sizes, int n_in, void* d_out, int out_size, void* d_ws, size_t ws_size, hipStream_t stream) {
    static int grid = 0;
    if (grid == 0) {
        if (n_in != 23 || out_size != MTOK * DM || ws_size < WS_END) { fprintf(stderr, "kernel_launch: unexpected problem (n_in %d, out %d, ws %zu < %zu)\n", n_in, out_size, ws_size, (size_t)WS_END); grid = -1; return; }
        int dev = 0, cus = 0, per_cu = 0;
        (void)hipGetDevice(&dev); (void)hipDeviceGetAttribute(&cus, hipDeviceAttributeMultiprocessorCount, dev);
        if (hipFuncSetAttribute((const void*)hybrid_fwd, hipFuncAttributeMaxDynamicSharedMemorySize, LDS_BYTES) != hipSuccess) { fprintf(stderr, "kernel_launch: hipFuncSetAttribute failed\n"); grid = -1; return; }
        if (hipOccupancyMaxActiveBlocksPerMultiprocessor(&per_cu, (const void*)hybrid_fwd, 512, LDS_BYTES) != hipSuccess || per_cu < 1) { fprintf(stderr, "kernel_launch: the occupancy query admits %d workgroups per CU for this kernel and LDS size; the grid barrier needs one resident workgroup per CU; nothing launched\n", per_cu); grid = -1; return; }
        (void)hipGetLastError();
        grid = cus;
        if (grid != 256) fprintf(stderr, "kernel_launch: %d CUs (expected 256)\n", grid);
        if (grid < 128) { fprintf(stderr, "kernel_launch: the S5 chunk-state phase needs at least 128 workgroups (one unit each); nothing launched\n"); grid = -1; return; }
    }
    if (grid < 0) return;
    Args a{};
    for (int i = 0; i < 23; ++i) a.in[i] = (const float*)d_in[i];
    a.out = (float*)d_out; a.ws = (unsigned char*)d_ws;
#if MK_COOP
    if (hipMemsetAsync(d_ws, 0, 16384, stream) != hipSuccess) { fprintf(stderr, "kernel_launch: memset of the barrier words failed\n"); return; }
    a.ph_lo = 0; a.ph_hi = NPHASE;
    void* kargs[] = {&a};
    hipError_t e = hipLaunchCooperativeKernel((const void*)hybrid_fwd, dim3(grid), dim3(512), kargs, LDS_BYTES, stream);
    if (e != hipSuccess) fprintf(stderr, "kernel_launch: cooperative launch failed: %s (grid %d)\n", hipGetErrorString(e), grid);
#else
    for (int ph = 0; ph < NPHASE; ++ph) { a.ph_lo = ph; a.ph_hi = ph + 1; hipLaunchKernelGGL(hybrid_fwd, dim3(grid), dim3(512), LDS_BYTES, stream, a); }
#endif
}
```

```cpp
#include <hip/hip_runtime.h>
#include <hip/hip_cooperative_groups.h>
#include <cstdio>
#include <cstdint>
namespace cg = cooperative_groups;

#define LAS __attribute__((address_space(3)))
#define PG8_LAS LAS
typedef unsigned short bf16_t;
typedef short bf16x8 __attribute__((ext_vector_type(8)));
typedef short s16x4 __attribute__((ext_vector_type(4)));
typedef float f32x2 __attribute__((ext_vector_type(2)));
typedef float f32x4 __attribute__((ext_vector_type(4)));
typedef float f32x16 __attribute__((ext_vector_type(16)));
typedef unsigned u32x2 __attribute__((ext_vector_type(2)));
typedef unsigned u32x4 __attribute__((ext_vector_type(4)));

constexpr int BATCH = 16, SEQ = 2048, DM = 1024, MTOK = BATCH * SEQ;
constexpr int SSMW = 512, NGRP = 32, NST = 64, GCH = 16;
constexpr int AW = 1536, NHEADS = 24, HD = 64, AOUT = 512;
constexpr int NIN = 7168, DFF = 2816;
constexpr int CT = 32, NCH = SEQ / CT;
constexpr int U2LD = 128 + CT * GCH;
constexpr float EPS = 1e-6f;
constexpr float LOG2E = 1.4426950408889634f;

constexpr size_t MiB = 1u << 20;
constexpr size_t WS_SS = 512 * 1024;
constexpr size_t WS_RINV = 640 * 1024;
constexpr size_t WS_APOW = 768 * 1024;
constexpr size_t WS_WIN = 1 * MiB, WS_WGLU = 15 * MiB, WS_WUP = 17 * MiB, WS_WOUT = 18 * MiB, WS_WGU = 20 * MiB, WS_WDN = 31 * MiB;
constexpr size_t WS_TMAT = 37 * MiB;
constexpr size_t WS_HMAT = 57 * MiB;
constexpr size_t WS_TAIL = 62 * MiB, WS_HEADG = 65 * MiB, WS_HEADU = 68 * MiB;
constexpr size_t WS_GA = 72 * MiB, WS_GB = 136 * MiB;
constexpr size_t WS_Q = 200 * MiB, WS_K = 296 * MiB, WS_V = 392 * MiB;
constexpr size_t WS_END = 488 * MiB;
constexpr size_t WS_YSSM = WS_Q, WS_TMPB = WS_Q + 32 * MiB, WS_MERGED = WS_Q + 96 * MiB, WS_X1B = WS_Q + 176 * MiB, WS_H = WS_Q;
constexpr size_t DO_XN = 0;
constexpr size_t DO_SCR = 0;
constexpr size_t DO_U2 = 80 * MiB;

constexpr int LDS_BYTES = 163840;
constexpr int ZS = 132;
constexpr int LDS_HALO = 139264;
constexpr int LDS_MISC = 143360;
constexpr int VT_BYTES = 32 * 192;

typedef __bf16 bf16x2_t __attribute__((ext_vector_type(2)));
__device__ __forceinline__ unsigned cvt_pk_bf16(float lo, float hi) { const f32x2 v = {lo, hi}; const bf16x2_t b = __builtin_convertvector(v, bf16x2_t); return __builtin_bit_cast(unsigned, b); }
__device__ __forceinline__ float bf_lo(unsigned w) { return __uint_as_float(w << 16); }
__device__ __forceinline__ float bf_hi(unsigned w) { return __uint_as_float(w & 0xffff0000u); }
__device__ __forceinline__ unsigned f2bf(float f) { unsigned u = __float_as_uint(f); return (u + 0x7fffu + ((u >> 16) & 1u)) >> 16; }
__device__ __forceinline__ float sigmoidp_(float x) { return __builtin_amdgcn_rcpf(1.0f + __builtin_amdgcn_exp2f(x)); }
__device__ __forceinline__ unsigned gate4_u8(f32x4 x) { const unsigned a = (unsigned)(sigmoidp_(x[0]) * 255.0f + 0.5f), b = (unsigned)(sigmoidp_(x[1]) * 255.0f + 0.5f), c = (unsigned)(sigmoidp_(x[2]) * 255.0f + 0.5f), d = (unsigned)(sigmoidp_(x[3]) * 255.0f + 0.5f);
    return a | (b << 8) | (c << 16) | (d << 24); }
__device__ __forceinline__ f32x4 gate4_f32(unsigned w) { return (f32x4){(float)(w & 255u), (float)((w >> 8) & 255u), (float)((w >> 16) & 255u), (float)(w >> 24)} * (1.0f / 255.0f); }
__device__ __forceinline__ float wave_sum(float v) {
#pragma unroll
    for (int o = 1; o < 64; o <<= 1) v += __shfl_xor(v, o);
    return v;
}
__device__ __forceinline__ float wave_max(float v) {
#pragma unroll
    for (int o = 1; o < 64; o <<= 1) v = fmaxf(v, __shfl_xor(v, o));
    return v;
}
__device__ __forceinline__ f32x2 gelu_pk(f32x2 v) {
    f32x2 n; n.x = __builtin_fmaxf(-__builtin_fabsf(v.x), -5.6f); n.y = __builtin_fmaxf(-__builtin_fabsf(v.y), -5.6f);
    f32x2 p = n * 3.360643278e-05f + 7.736645178e-04f; p = p * n + 8.095245171e-03f; p = p * n + 5.343466881e-02f; p = p * n + (-4.587538301e-01f); p = p * n + 1.151207531e+00f; p = p * n + (-9.999924068e-01f);
    f32x2 e; e.x = __builtin_amdgcn_exp2f(p.x); e.y = __builtin_amdgcn_exp2f(p.y);
    f32x2 r; r.x = __builtin_fmaxf(v.x, 0.f); r.y = __builtin_fmaxf(v.y, 0.f);
    return __builtin_elementwise_fma(n, e, r);
}
__device__ __forceinline__ f32x4 gelu4(f32x4 v) { const f32x2 a = gelu_pk((f32x2){v[0], v[1]}), b = gelu_pk((f32x2){v[2], v[3]}); return (f32x4){a.x, a.y, b.x, b.y}; }
__device__ __forceinline__ u32x4 pack8(f32x4 a, f32x4 b) { u32x4 w; w.x = cvt_pk_bf16(a[0], a[1]); w.y = cvt_pk_bf16(a[2], a[3]); w.z = cvt_pk_bf16(b[0], b[1]); w.w = cvt_pk_bf16(b[2], b[3]); return w; }
__device__ __forceinline__ void unpack8(u32x4 w, f32x4& a, f32x4& b) { a = (f32x4){bf_lo(w.x), bf_hi(w.x), bf_lo(w.y), bf_hi(w.y)}; b = (f32x4){bf_lo(w.z), bf_hi(w.z), bf_lo(w.w), bf_hi(w.w)}; }

namespace pg8 {
constexpr int BM = 256, BK = 64, HALF = 128, HTB = HALF * BK * 2  , STAGE_BYTES = 8 * HTB, NXCD = 8, WGM = 8;
__host__ __device__ __forceinline__ int lds_byte(int r, int c) { const int st = (r >> 4) * 2 + (c >> 5), rr = r & 15, cc = c & 31, ob = rr * 64 + cc * 2; return st * 1024 + (ob ^ (((ob >> 9) & 1) << 5)); }
__host__ __device__ __forceinline__ void stage_rc(int b, int& R, int& C) { const int st = b / 1024, sb = b % 1024, swz = sb ^ (((sb >> 9) & 1) << 5); R = (st >> 1) * 16 + swz / 64; C = (st & 1) * 32 + (swz % 64) / 2; }
__host__ __device__ __forceinline__ int perm32(int rho) { const int n = rho >> 4, i = rho & 15; return 8 * (i >> 2) + 4 * n + (i & 3); }

struct Unit { int pm, pn, ar, br, amode; };
struct Gemm { const bf16_t* A; const bf16_t* Bt; int K, lda, ldb; int ablk = 0; };

template <int MODE>
struct StaticOrder {
    int nM, nN, nwg, G, c; bool inproj = false;
    __device__ void init(int nM_, int nN_, int G_, int c_) { nM = nM_; nN = nN_; nwg = nM * nN; G = G_; c = c_; }
    __device__ bool next(int i, Unit& u) const {
        const long L = (long)i * G + c; if (L >= nwg) return false;
        int wgid = (int)L; { const int q = nwg / NXCD, r = nwg % NXCD, xcd = wgid % NXCD, off = wgid / NXCD; wgid = (xcd < r ? xcd * (q + 1) : r * (q + 1) + (xcd - r) * q) + off; }
        const int nig = WGM * nN, gid = wgid / nig, fm = gid * WGM, gsz = (nM - fm) < WGM ? (nM - fm) : WGM;
        u.pm = fm + ((wgid % nig) % gsz); u.pn = (wgid % nig) / gsz;
        u.ar = 256 * u.pm; u.amode = 0;
        if (inproj) { const int pn = u.pn;
            if (pn >= 14 && pn < 20) u.amode = 1 + ((pn - 14) >> 1);
            else if (pn >= 2 && pn < 14) { const int dsel = ((pn - 2) % 6) >> 1; u.amode = dsel == 2 ? 4 : (dsel == 1 ? 5 : 0); } }
        u.br = MODE == 0 ? 256 * u.pn : (MODE == 1 ? 128 * (u.pm >> 2) : 512 * (u.pm >> 2) + 256 * u.pn);
        return true;
    }
    __device__ __forceinline__ void a_ready(const Unit&) const {}
    __device__ __forceinline__ void done(const Unit&) const {}
};
template <class Epi, class Sched, bool ALIGN_EPI = false, bool SP2 = false>
__device__ __forceinline__ void gemm_phase(PG8_LAS unsigned char* lds, const Gemm g, const Sched& S, const Epi& E) {
    const int tid = threadIdx.x, wid = __builtin_amdgcn_readfirstlane(tid >> 6), lane = tid & 63, wr = wid >> 2, wc = wid & 3, fr = lane & 15, fq = lane >> 4;
    const int nt = g.K / BK, lda = g.ablk ? BK : g.lda, ldb = g.ldb;
    unsigned voffA[2], voffAn[2], voffB[2];
#pragma unroll
    for (int i = 0; i < 2; ++i) { int R, C; stage_rc(tid * 16 + i * 8192, R, C); const int Rb = Epi::PERM ? ((R & ~31) + perm32(R & 31)) : R;
        const int Ra = Epi::AROW4 ? ((R & 64) + 4 * (R & 15) + ((R >> 4) & 3)) : R;
        voffA[i] = (unsigned)(Ra * lda + C) * 2u; voffB[i] = (unsigned)(Rb * ldb + C) * 2u; }
    const size_t kstep = (size_t)(BK * 2);
    const size_t kstepA = g.ablk ? (size_t)(BM * BK * 2) : kstep, arow = g.ablk ? (size_t)g.K * 2 : (size_t)g.lda * 2;
    size_t hsA = (size_t)HALF * lda * 2, hsAn = hsA; const size_t hsB = (size_t)HALF * ldb * 2;
    auto set_amode = [&](int mode, unsigned* v, size_t& hs) {
        const int lg = mode >= 1 && mode <= 3 ? 2 * (mode - 1) : 0;
        _Pragma("unroll") for (int i = 0; i < 2; ++i) { int R, C; stage_rc(tid * 16 + i * 8192, R, C); int Ra = R;
            const int wr_ = (R >> 6) & 1, m_ = (R >> 4) & 3, fr_ = R & 15, hi_ = fr_ & 1, cs_ = 8 * wr_ + (fr_ >> 1);
            if (mode >= 1 && mode <= 3) Ra = (((16 * (cs_ & ((16 >> lg) - 1)) + 4 * hi_ + m_)) << lg) + (cs_ >> (4 - lg));
            else if (mode == 4) Ra = 16 * fr_ + 4 * wr_ + m_;
            else if (mode == 5) Ra = 64 * wr_ + 4 * fr_ + m_;
            v[i] = (unsigned)(Ra * lda + C) * 2u; }
        hs = (mode >= 1 && mode <= 3) ? (size_t)(8 << lg) * lda * 2 : (mode == 4 ? (size_t)8 * lda * 2 : (size_t)HALF * lda * 2); };
    const unsigned ldsw = (unsigned)wid * 1024u;
    const int aoff = lds_byte(wr * 64 + fr, fq * 8), boff = lds_byte(wc * 32 + fr, fq * 8);
#define PG8_SA(b, h) (((b) * 2 + (h)) * HTB)
#define PG8_SB(b, h) ((4 + (b) * 2 + (h)) * HTB)
#define PG8_STAGE(bufoff, gbase, voff) do { _Pragma("unroll") for (int _i = 0; _i < 2; ++_i) \
        __builtin_amdgcn_global_load_lds((const unsigned*)((const char*)(gbase) + (voff)[_i]), (PG8_LAS unsigned*)(lds + (bufoff) + ldsw + _i * 8192), 16, 0, 0); } while (0)
#define PG8_LDA(dst, b, h) do { _Pragma("unroll") for (int m = 0; m < 4; ++m) _Pragma("unroll") for (int k = 0; k < 2; ++k) dst[m][k] = *(const PG8_LAS bf16x8*)(lds + PG8_SA(b, h) + aoff + m * 2048 + k * 1024); } while (0)
#define PG8_LDB(dst, b, h) do { _Pragma("unroll") for (int n = 0; n < 2; ++n) _Pragma("unroll") for (int k = 0; k < 2; ++k) dst[n][k] = *(const PG8_LAS bf16x8*)(lds + PG8_SB(b, h) + boff + n * 2048 + k * 1024); } while (0)
#define PG8_MMA(ai, bj, At, Bt) do { __builtin_amdgcn_s_setprio(1); _Pragma("unroll") for (int m = 0; m < 4; ++m) _Pragma("unroll") for (int n = 0; n < 2; ++n) _Pragma("unroll") for (int k = 0; k < 2; ++k) \
        acc[ai][bj][m][n] = __builtin_amdgcn_mfma_f32_16x16x32_bf16(Bt[n][k], At[m][k], acc[ai][bj][m][n], 0, 0, 0); __builtin_amdgcn_s_setprio(0); } while (0)
#define PG8_WAIT_V(n) asm volatile("s_waitcnt vmcnt(" #n ")" ::: "memory")
#define PG8_WAIT_V8R do { if (relax_) { if constexpr (!(ALIGN_EPI && SP2)) { PG8_WAIT_V(8); } else if constexpr (Epi::VM_MIN >= 40) { PG8_WAIT_V(50); } else if constexpr (Epi::VM_MIN >= 32) { PG8_WAIT_V(42); } else if constexpr (Epi::VM_MIN >= 24) { PG8_WAIT_V(34); } else if constexpr (Epi::VM_MIN >= 16) { PG8_WAIT_V(26); } else if (relax16_) { PG8_WAIT_V(26); } else { PG8_WAIT_V(18); } } else { PG8_WAIT_V(8); } } while (0)
#define PG8_WAIT_L(n) asm volatile("s_waitcnt lgkmcnt(" #n ")" ::: "memory")
#define PG8_BAR __builtin_amdgcn_s_barrier()
#define PG8_SCHED __builtin_amdgcn_sched_barrier(0)
    Unit cur, nxt; int ui = 0, prv_pn = 0;
    if (!S.next(0, cur)) return;
    if constexpr (Epi::AMODES) { set_amode(cur.amode, voffA, hsA); }
    f32x4 acc[2][2][4][2];
#pragma unroll
    for (int a = 0; a < 2; ++a)
#pragma unroll
        for (int b = 0; b < 2; ++b)
#pragma unroll
            for (int m = 0; m < 4; ++m)
#pragma unroll
                for (int n = 0; n < 2; ++n) acc[a][b][m][n] = (f32x4){0.f, 0.f, 0.f, 0.f};
    bf16x8 At[4][2], B0[2][2], B1[2][2];
    const char* cA = (const char*)g.A + (size_t)cur.ar * arow; const char* cB = (const char*)g.Bt + (size_t)cur.br * ldb * 2;
    S.a_ready(cur);
    if constexpr (SP2) {
        PG8_STAGE(PG8_SB(0, 0), cB, voffB); PG8_STAGE(PG8_SB(0, 1), cB + hsB, voffB); PG8_STAGE(PG8_SA(0, 0), cA, voffA); PG8_STAGE(PG8_SA(0, 1), cA + hsA, voffA);
        if (wr == 1) PG8_BAR;
        PG8_WAIT_V(2); PG8_BAR;
        PG8_STAGE(PG8_SB(1, 0), cB + kstep, voffB); PG8_STAGE(PG8_SA(1, 0), cA + kstepA, voffA); PG8_STAGE(PG8_SB(1, 1), cB + hsB + kstep, voffB);
        PG8_WAIT_V(6); PG8_BAR;
    } else {
        PG8_STAGE(PG8_SB(0, 0), cB, voffB); PG8_STAGE(PG8_SA(0, 0), cA, voffA); PG8_STAGE(PG8_SB(0, 1), cB + hsB, voffB); PG8_STAGE(PG8_SA(0, 1), cA + hsA, voffA);
        if (wr == 1) PG8_BAR;
        PG8_WAIT_V(4); PG8_BAR;
        PG8_STAGE(PG8_SB(1, 0), cB + kstep, voffB); PG8_STAGE(PG8_SA(1, 0), cA + kstepA, voffA); PG8_STAGE(PG8_SB(1, 1), cB + hsB + kstep, voffB);
        PG8_WAIT_V(6); PG8_BAR;
    }
    for (;;) {
        const bool has_next = S.next(ui + 1, nxt);
        if constexpr (Epi::AMODES) { set_amode(has_next ? nxt.amode : cur.amode, voffAn, hsAn); }
        const char* nA = has_next ? (const char*)g.A + (size_t)nxt.ar * arow : cA; const char* nB = has_next ? (const char*)g.Bt + (size_t)nxt.br * ldb * 2 : cB;
        for (int t = 0; t < nt; t += 2) {
            const bool last = (t == nt - 2);
            const char* a1 = cA + (size_t)(t + 1) * kstepA;
            const char* a2 = last ? nA : cA + (size_t)(t + 2) * kstepA; const char* b2 = last ? nB : cB + (size_t)(t + 2) * kstep;
            const char* a3 = a2 + kstepA; const char* b3 = b2 + kstep;
            if (last && has_next) S.a_ready(nxt);
            unsigned vA2_[2]; size_t hsA2;
            if constexpr (Epi::AMODES) { vA2_[0] = last ? voffAn[0] : voffA[0]; vA2_[1] = last ? voffAn[1] : voffA[1]; hsA2 = last ? hsAn : hsA; } else { vA2_[0] = voffA[0]; vA2_[1] = voffA[1]; hsA2 = hsA; }
            const bool relax_ = __builtin_amdgcn_readfirstlane((int)(Epi::VM_MIN >= 8 && t == 0 && ui > 0)) != 0;
            const bool relax16_ = __builtin_amdgcn_readfirstlane((int)(Epi::AMODES && t == 0 && ui > 0 && prv_pn < 20)) != 0;
            if constexpr (SP2) {
            PG8_LDB(B0, 0, 0); PG8_LDB(B1, 0, 1); PG8_SCHED; PG8_LDA(At, 0, 0); PG8_STAGE(PG8_SA(1, 1), a1 + hsA, voffA);
            PG8_WAIT_V8R; PG8_WAIT_L(0); PG8_BAR; PG8_MMA(0, 0, At, B0); PG8_MMA(0, 1, At, B1); PG8_BAR; PG8_SCHED;
            PG8_LDA(At, 0, 1); PG8_STAGE(PG8_SB(0, 0), b2, voffB); PG8_STAGE(PG8_SB(0, 1), b2 + hsB, voffB); PG8_STAGE(PG8_SA(0, 0), a2, vA2_);
            PG8_WAIT_V8R; PG8_WAIT_L(0); PG8_BAR; PG8_MMA(1, 0, At, B0); PG8_MMA(1, 1, At, B1); PG8_BAR; PG8_SCHED;
            PG8_LDB(B0, 1, 0); PG8_LDB(B1, 1, 1); PG8_SCHED; PG8_LDA(At, 1, 0); PG8_STAGE(PG8_SA(0, 1), a2 + hsA2, vA2_);
            PG8_WAIT_V8R; PG8_WAIT_L(0); PG8_BAR; PG8_MMA(0, 0, At, B0); PG8_MMA(0, 1, At, B1); PG8_BAR; PG8_SCHED;
            PG8_LDA(At, 1, 1); PG8_STAGE(PG8_SB(1, 0), b3, voffB); PG8_STAGE(PG8_SB(1, 1), b3 + hsB, voffB); PG8_STAGE(PG8_SA(1, 0), a3, vA2_);
            PG8_WAIT_V(8); PG8_WAIT_L(0); PG8_BAR; PG8_MMA(1, 0, At, B0); PG8_MMA(1, 1, At, B1); PG8_BAR; PG8_SCHED;
            } else {
            PG8_LDB(B0, 0, 0); PG8_SCHED; PG8_LDA(At, 0, 0); PG8_STAGE(PG8_SA(1, 1), a1 + hsA, voffA);
            PG8_WAIT_L(8); PG8_BAR; PG8_WAIT_L(0); PG8_MMA(0, 0, At, B0); PG8_BAR; PG8_SCHED;
            PG8_LDB(B1, 0, 1); PG8_STAGE(PG8_SB(0, 0), b2, voffB);
            PG8_BAR; PG8_WAIT_L(0); PG8_MMA(0, 1, At, B1); PG8_BAR;
            PG8_LDA(At, 0, 1); PG8_STAGE(PG8_SA(0, 0), a2, vA2_);
            PG8_BAR; PG8_WAIT_L(0); PG8_MMA(1, 0, At, B0); PG8_BAR; PG8_SCHED;
            PG8_STAGE(PG8_SB(0, 1), b2 + hsB, voffB);
            PG8_WAIT_V(6); PG8_BAR; PG8_MMA(1, 1, At, B1); PG8_BAR;
            PG8_LDB(B0, 1, 0); PG8_SCHED; PG8_LDA(At, 1, 0); PG8_STAGE(PG8_SA(0, 1), a2 + hsA2, vA2_);
            PG8_WAIT_L(8); PG8_BAR; PG8_WAIT_L(0); PG8_MMA(0, 0, At, B0); PG8_BAR; PG8_SCHED;
            PG8_LDB(B1, 1, 1); PG8_STAGE(PG8_SB(1, 0), b3, voffB);
            PG8_BAR; PG8_WAIT_L(0); PG8_MMA(0, 1, At, B1); PG8_BAR;
            PG8_LDA(At, 1, 1); PG8_STAGE(PG8_SA(1, 0), a3, vA2_);
            PG8_BAR; PG8_WAIT_L(0); PG8_MMA(1, 0, At, B0); PG8_BAR; PG8_SCHED;
            PG8_STAGE(PG8_SB(1, 1), b3 + hsB, voffB);
            PG8_WAIT_V(6); PG8_BAR; PG8_MMA(1, 1, At, B1); PG8_BAR;
            }
        }
        if constexpr (ALIGN_EPI) { if (wr == 0) PG8_BAR; }
        if constexpr (ALIGN_EPI && SP2) {
            if (has_next) { if constexpr (Epi::AMODES) { PG8_STAGE(PG8_SA(1, 1), nA + kstepA + hsAn, voffAn); } else { PG8_STAGE(PG8_SA(1, 1), nA + kstepA + hsA, voffA); } } }
        if constexpr (!Epi::AFTER_DRAIN) { E(acc, cur, wr, wc, fr, fq); S.done(cur); }
        if (!has_next) break;
#pragma unroll
        for (int a = 0; a < 2; ++a)
#pragma unroll
            for (int b = 0; b < 2; ++b)
#pragma unroll
                for (int m = 0; m < 4; ++m)
#pragma unroll
                    for (int n = 0; n < 2; ++n) acc[a][b][m][n] = (f32x4){0.f, 0.f, 0.f, 0.f};
        prv_pn = cur.pn; cur = nxt; cA = nA; cB = nB; ++ui;
        if constexpr (Epi::AMODES) { voffA[0] = voffAn[0]; voffA[1] = voffAn[1]; hsA = hsAn; }
        if constexpr (ALIGN_EPI) { if (wr == 1) PG8_BAR; }
    }
    PG8_WAIT_V(0);
    if constexpr (!ALIGN_EPI) { if (wr == 0) PG8_BAR; }
    PG8_BAR;
    if constexpr (Epi::AFTER_DRAIN) { E.fused(acc, cur, wr, wc, fr, fq, lds, wid, lane); S.done(cur); }
#undef PG8_SA
#undef PG8_SB
#undef PG8_STAGE
#undef PG8_LDA
#undef PG8_LDB
#undef PG8_MMA
#undef PG8_WAIT_V
#undef PG8_WAIT_V8R
#undef PG8_WAIT_L
#undef PG8_BAR
#undef PG8_SCHED
}}

using pg8::Unit;
typedef f32x4 Acc[2][2][4][2];

#ifndef ST_AUX
#define ST_AUX 18
#endif
template <int W> __device__ __forceinline__ size_t blk_idx(int row, int c) { return ((size_t)((row >> 8) * (W / 64) + (c >> 6)) * 256 + (row & 255)) * 64 + (c & 63); }

__device__ __forceinline__ void st16b(bf16_t* base, bf16_t* p, u32x4 v) {
    const __amdgpu_buffer_rsrc_t r = __builtin_amdgcn_make_buffer_rsrc((void*)base, (short)0, 0x7fffffff, 0x00020000);
    __builtin_amdgcn_raw_buffer_store_b128(v, r, (int)((char*)p - (char*)base), 0, ST_AUX);
}
struct EpiInProj {
    static constexpr bool PERM = true, AFTER_DRAIN = false; static constexpr int VM_MIN = 8;
    static constexpr bool AROW4 = false, AMODES = true;
    bf16_t *U2, *Q, *K, *V, *GA, *GB; const float *qg, *kg;
    __device__ __forceinline__ void operator()(Acc& acc, const Unit& u, int wr, int wc, int fr, int fq) const {
        const int pn = u.pn, row0 = u.pm * 256 + wr * 64 + fr;
        if (pn < 2) {
#pragma unroll
            for (int ai = 0; ai < 2; ++ai)
#pragma unroll
                for (int m = 0; m < 4; ++m) { const int row = row0 + ai * 128 + m * 16, b = row >> 11, t = row & 2047, c = t >> 5, i = t & 31;
#pragma unroll
                    for (int bj = 0; bj < 2; ++bj) { const int cl = 256 * pn + 128 * bj + 32 * wc + 8 * fq, g = cl >> 4;
                        bf16_t* dst = U2 + ((size_t)(g * 1024 + b * 64 + c) * U2LD + 128 + i * 16 + (cl & 15));
                        *(u32x4*)dst = pack8(acc[ai][bj][m][0], acc[ai][bj][m][1]);     } }
        } else if (pn < 14) {
            const bool isq = pn < 8; const int head = 4 * (isq ? pn - 2 : pn - 8) + wc, lg = 2 * (head >> 3);
            const float* gs = isq ? qg : kg; bf16_t* base = (isq ? Q : K) + 8 * (32 * (fq & 1)) + 512 * (fq >> 1);
            const float sc = isq ? 0.125f * LOG2E : 1.0f;
            f32x4 gv[2][2];
#pragma unroll
            for (int bj = 0; bj < 2; ++bj)
#pragma unroll
                for (int n = 0; n < 2; ++n) gv[bj][n] = *(const f32x4*)(gs + 32 * bj + 8 * fq + 4 * n) * sc;
#pragma unroll
            for (int ai = 0; ai < 2; ++ai)
#pragma unroll
                for (int m = 0; m < 4; ++m) { float ss = 0.f;
#pragma unroll
                    for (int bj = 0; bj < 2; ++bj)
#pragma unroll
                        for (int n = 0; n < 2; ++n) { const f32x4 x = acc[ai][bj][m][n]; ss += (x[0] * x[0] + x[1] * x[1]) + (x[2] * x[2] + x[3] * x[3]); }
                    ss += __shfl_xor(ss, 16); ss += __shfl_xor(ss, 32);
                    const float rs = __builtin_amdgcn_rsqf(ss * (1.0f / 64.0f) + EPS);
                    const int trow = lg == 0 ? wr * 64 + fr + ai * 128 + m * 16 : (lg == 2 ? 128 * ai + 64 * wr + 4 * fr + m : 16 * fr + 8 * ai + 4 * wr + m);
                    const int row = u.pm * 256 + trow, b = row >> 11, t = row & 2047, tp = ((t & ((1 << lg) - 1)) << (11 - lg)) + (t >> lg);
                    bf16_t* rowp = base + ((size_t)(b * NHEADS + head) * SEQ + (tp & ~31)) * HD + 8 * (tp & 31);
#pragma unroll
                    for (int bj = 0; bj < 2; ++bj) st16b(isq ? Q : K, rowp + 1024 * bj, pack8(acc[ai][bj][m][0] * rs * gv[bj][0], acc[ai][bj][m][1] * rs * gv[bj][1])); }
        } else if (pn < 20) {
            const int lg = 2 * ((pn - 14) >> 1), hi_ = fr & 1, cs = 8 * wr + (fr >> 1), c = cs >> (4 - lg), sg = cs & ((16 >> lg) - 1);
            const int tile_t0 = (u.pm * 256) & 2047, b = (u.pm * 256) >> 11;
            const int rb16 = c * (2048 >> lg) + (tile_t0 >> lg) + 16 * sg;
            const size_t blk = (size_t)(rb16 & ~31) * HD + (size_t)(2 * (wc & 1) + ((rb16 >> 4) & 1)) * 512 + hi_ * 256 + fq * 8;
#pragma unroll
            for (int bj = 0; bj < 2; ++bj) { const int head = 4 * (pn - 14) + 2 * bj + (wc >> 1); bf16_t* hp = V + (size_t)(b * NHEADS + head) * SEQ * HD + blk;
#pragma unroll
                for (int n = 0; n < 2; ++n)
#pragma unroll
                    for (int e = 0; e < 4; ++e) { u32x4 w;
                        w.x = cvt_pk_bf16(acc[0][bj][0][n][e], acc[0][bj][1][n][e]); w.y = cvt_pk_bf16(acc[0][bj][2][n][e], acc[0][bj][3][n][e]);
                        w.z = cvt_pk_bf16(acc[1][bj][0][n][e], acc[1][bj][1][n][e]); w.w = cvt_pk_bf16(acc[1][bj][2][n][e], acc[1][bj][3][n][e]);
                        st16b(V, hp + (4 * n + e) * 32, w); } }
        } else {
            int fq_ = fq; asm volatile("" : "+v"(fq_));
            unsigned char* base = (unsigned char*)(pn < 24 ? GA : GB) + 256 * (pn < 24 ? pn - 20 : pn - 24) + 64 * wc + 16 * fq_;
#pragma unroll
            for (int ai = 0; ai < 2; ++ai)
#pragma unroll
                for (int m = 0; m < 4; ++m) { unsigned char* rowp = base + (size_t)(row0 + ai * 128 + m * 16) * DM; u32x4 w;
                    w.x = gate4_u8(acc[ai][0][m][0]); w.y = gate4_u8(acc[ai][0][m][1]); w.z = gate4_u8(acc[ai][1][m][0]); w.w = gate4_u8(acc[ai][1][m][1]);
                    st16b(pn < 24 ? GA : GB, (bf16_t*)rowp, w); __builtin_amdgcn_sched_barrier(0); }
        }
    }
};

struct EpiSsmState {
    static constexpr bool PERM = false, AFTER_DRAIN = true; static constexpr int VM_MIN = 0; static constexpr bool AROW4 = false, AMODES = false;
    bf16_t* U2; const f32x2* APOW;
    __device__ __forceinline__ void fused(Acc& acc, const Unit& u, int wr, int wc, int fr, int fq, LAS unsigned char* lds, int wid, int lane) const {
        LAS float* Z = (LAS float*)lds;
#pragma unroll
        for (int ai = 0; ai < 2; ++ai)
#pragma unroll
            for (int m = 0; m < 4; ++m)
#pragma unroll
                for (int n = 0; n < 2; ++n) *(LAS f32x4*)(Z + (ai * 128 + wr * 64 + m * 16 + fr) * ZS + 32 * wc + 16 * n + 4 * fq) = acc[ai][0][m][n];
        asm volatile("s_waitcnt lgkmcnt(0)" ::: "memory"); __builtin_amdgcn_s_barrier(); asm volatile("" ::: "memory");
        const int tid = wid * 64 + lane;
        if (tid < 256) {
            const int bl = tid >> 6, p = tid & 63, g = u.pm >> 2;
            const f32x2 a = APOW[g * 64 + p]; float sr = 0.f, si = 0.f;
            bf16_t* dst = U2 + (size_t)(u.pm * 256 + bl * 64) * U2LD + p; const LAS float* zp = Z + (bl * 64) * ZS + p;
            float zr[NCH], zi[NCH];
#pragma unroll
            for (int c = 0; c < NCH; ++c) { zr[c] = zp[c * ZS]; zi[c] = zp[c * ZS + 64]; }
#pragma unroll
            for (int c = 0; c < NCH; ++c) {
                dst[(size_t)c * U2LD] = (bf16_t)f2bf(sr); dst[(size_t)c * U2LD + 64] = (bf16_t)f2bf(si);
                const float nr = a.x * sr - a.y * si + zr[c], ni = a.x * si + a.y * sr + zi[c]; sr = nr; si = ni;
            }
        }
        asm volatile("s_waitcnt lgkmcnt(0)" ::: "memory"); __builtin_amdgcn_s_barrier(); asm volatile("" ::: "memory");
    }
};

struct EpiSsmOut {
    static constexpr bool PERM = true, AFTER_DRAIN = false; static constexpr int VM_MIN = 16; static constexpr bool AROW4 = false, AMODES = false;
    bf16_t* Y;
    __device__ __forceinline__ void operator()(Acc& acc, const Unit& u, int wr, int wc, int fr, int fq) const {
        const int g = u.pm >> 2;
#pragma unroll
        for (int ai = 0; ai < 2; ++ai) {
#pragma unroll
            for (int bj = 0; bj < 2; ++bj) { const int n0 = 256 * u.pn + 128 * bj + 32 * wc + 8 * fq, i = n0 >> 4, co0 = n0 & 15;
#pragma unroll
                for (int m = 0; m < 4; ++m) { const int rl = 256 * (u.pm & 3) + 128 * ai + 64 * wr + 16 * m + fr, b = rl >> 6, c = rl & 63;
                    const f32x4 y0 = gelu4(acc[ai][bj][m][0]), y1 = gelu4(acc[ai][bj][m][1]);
                    *(u32x4*)(Y + blk_idx<SSMW>(b * SEQ + c * CT + i, g * 16 + co0)) = pack8(y0, y1); } } }
    }
};

struct EpiUp {
    static constexpr bool PERM = true, AFTER_DRAIN = false; static constexpr int VM_MIN = 24; static constexpr bool AROW4 = false, AMODES = false;
    const bf16_t* GB; bf16_t* T;
    __device__ __forceinline__ void operator()(Acc& acc, const Unit& u, int wr, int wc, int fr, int fq) const {
        const size_t off0 = (size_t)(u.pm * 256 + wr * 64 + fr) * DM + 256 * u.pn + 32 * wc + 8 * fq;
        const unsigned char* gbase = (const unsigned char*)GB + (size_t)(u.pm * 256 + wr * 64 + fr) * DM + 256 * u.pn + 64 * wc + 16 * fq;
#pragma unroll
        for (int ai = 0; ai < 2; ++ai) { u32x4 gq[4];
#pragma unroll
            for (int m = 0; m < 4; ++m) gq[m] = *(const u32x4*)(gbase + (size_t)(ai * 128 + m * 16) * DM);
            __builtin_amdgcn_sched_barrier(0);
#pragma unroll
            for (int m = 0; m < 4; ++m)
#pragma unroll
                for (int bj = 0; bj < 2; ++bj) { const f32x4 ga = gate4_f32(bj == 0 ? gq[m].x : gq[m].z), gb = gate4_f32(bj == 0 ? gq[m].y : gq[m].w);
                    *(u32x4*)(T + off0 + (size_t)(ai * 128 + m * 16) * DM + 128 * bj) = pack8(acc[ai][bj][m][0] * ga, acc[ai][bj][m][1] * gb); } }
    }
};

struct EpiGlu {
    static constexpr bool PERM = true, AFTER_DRAIN = false; static constexpr int VM_MIN = 24; static constexpr bool AROW4 = false, AMODES = false;
    const bf16_t *GA, *T; bf16_t* MG;
    __device__ __forceinline__ void operator()(Acc& acc, const Unit& u, int wr, int wc, int fr, int fq) const {
        const size_t off0 = (size_t)(u.pm * 256 + wr * 64 + fr) * DM + 128 * u.pn + 32 * wc + 8 * fq;
        const unsigned char* gbase = (const unsigned char*)GA + (size_t)(u.pm * 256 + wr * 64 + fr) * DM + 256 * (u.pn >> 1) + 64 * wc + 16 * fq + 8 * (u.pn & 1);
#pragma unroll
        for (int ai = 0; ai < 2; ++ai) { u32x2 gq[4]; u32x4 tq[4];
#pragma unroll
            for (int m = 0; m < 4; ++m) { gq[m] = *(const u32x2*)(gbase + (size_t)(ai * 128 + m * 16) * DM); tq[m] = *(const u32x4*)(T + off0 + (size_t)(ai * 128 + m * 16) * DM); }
            __builtin_amdgcn_sched_barrier(0);
#pragma unroll
            for (int m = 0; m < 4; ++m) { f32x4 ta, tb; unpack8(tq[m], ta, tb); const f32x4 ga = gate4_f32(gq[m].x), gb = gate4_f32(gq[m].y);
                f32x4 va = acc[ai][0][m][0], vb = acc[ai][0][m][1]; const f32x4 sa = acc[ai][1][m][0], sb = acc[ai][1][m][1];
#pragma unroll
                for (int e = 0; e < 4; ++e) { va[e] = ga[e] * va[e] * sigmoidp_(sa[e]) + ta[e]; vb[e] = gb[e] * vb[e] * sigmoidp_(sb[e]) + tb[e]; }
                *(u32x4*)(MG + blk_idx<DM>(u.pm * 256 + wr * 64 + fr + ai * 128 + m * 16, 128 * u.pn + 32 * wc + 8 * fq)) = pack8(va, vb); } }
    }
};

struct EpiOut {
    static constexpr bool PERM = true, AFTER_DRAIN = false; static constexpr int VM_MIN = 40; static constexpr bool AROW4 = false, AMODES = false;
    const bf16_t* XN; const float* RINV; bf16_t* X1B; float* SS;
    __device__ __forceinline__ void operator()(Acc& acc, const Unit& u, int wr, int wc, int fr, int fq) const {
        const size_t off0 = (size_t)(u.pm * 256 + wr * 64 + fr) * DM + 256 * u.pn + 32 * wc + 8 * fq;
#pragma unroll
        for (int ai = 0; ai < 2; ++ai) { u32x4 xq[4][2]; float ri[4];
#pragma unroll
            for (int m = 0; m < 4; ++m) { ri[m] = RINV[u.pm * 256 + ai * 128 + wr * 64 + m * 16 + fr];
#pragma unroll
                for (int bj = 0; bj < 2; ++bj) xq[m][bj] = *(const u32x4*)(XN + off0 + (size_t)(ai * 128 + m * 16) * DM + 128 * bj); }
            __builtin_amdgcn_sched_barrier(0);
#pragma unroll
            for (int m = 0; m < 4; ++m) { const int row = u.pm * 256 + ai * 128 + wr * 64 + m * 16 + fr; const size_t off = off0 + (size_t)(ai * 128 + m * 16) * DM; float ss = 0.f;
#pragma unroll
                for (int bj = 0; bj < 2; ++bj) { f32x4 xa, xb; unpack8(xq[m][bj], xa, xb); const f32x4 a = acc[ai][bj][m][0] + xa * ri[m], b = acc[ai][bj][m][1] + xb * ri[m];
                    *(u32x4*)(X1B + off + 128 * bj) = pack8(a, b);
                    ss += (a[0] * a[0] + a[1] * a[1]) + (a[2] * a[2] + a[3] * a[3]) + (b[0] * b[0] + b[1] * b[1]) + (b[2] * b[2] + b[3] * b[3]); }
                ss += __shfl_xor(ss, 16); ss += __shfl_xor(ss, 32);
                if (fq == 0) atomicAdd(SS + row, ss); } }
    }
};

__device__ __forceinline__ float dpp_shr1(float old, float src) { return __int_as_float(__builtin_amdgcn_update_dpp(__float_as_int(old), __float_as_int(src), 0x111, 0xF, 0xF, false)); }
__device__ __forceinline__ float dpp_shr2(float old, float src) { return __int_as_float(__builtin_amdgcn_update_dpp(__float_as_int(old), __float_as_int(src), 0x112, 0xF, 0xF, false)); }

__device__ __forceinline__ size_t h_idx(int row, int f) { return ((size_t)((row >> 8) * (DFF / 64) + (f >> 6)) * 256 + (row & 255)) * 64 + (f & 63); }

struct EpiFfn {
    static constexpr bool PERM = true, AFTER_DRAIN = false; static constexpr int VM_MIN = 16; static constexpr bool AROW4 = true, AMODES = false;
    const float *SS, *cw, *cb; bf16_t* H; float *TAIL, *HEADG, *HEADU; LAS float* halo;
    __device__ __forceinline__ void operator()(Acc& acc, const Unit& u, int wr, int wc, int fr, int fq) const {
        const int f0 = 128 * u.pn + 32 * wc + 8 * fq, rowb = u.pm * 256 + wr * 64 + 4 * fr;
        f32x4 w0[2], w1[2], w2[2], bv[2];
#pragma unroll
        for (int n = 0; n < 2; ++n) { w0[n] = *(const f32x4*)(cw + f0 + 4 * n); w1[n] = *(const f32x4*)(cw + DFF + f0 + 4 * n); w2[n] = *(const f32x4*)(cw + 2 * DFF + f0 + 4 * n); bv[n] = *(const f32x4*)(cb + f0 + 4 * n); }
#pragma unroll
        for (int ai = 0; ai < 2; ++ai) { const f32x4 ssv = *(const f32x4*)(SS + rowb + ai * 128);
#pragma unroll
            for (int m = 0; m < 4; ++m) { const float rs = __builtin_amdgcn_rsqf(ssv[m] * (1.0f / DM) + EPS);
#pragma unroll
                for (int bj = 0; bj < 2; ++bj)
#pragma unroll
                    for (int n = 0; n < 2; ++n) acc[ai][bj][m][n] *= rs; } }
        if (fr == 15) {
#pragma unroll
            for (int ai = 0; ai < 2; ++ai)
#pragma unroll
                for (int ms = 0; ms < 2; ++ms)
#pragma unroll
                    for (int n = 0; n < 2; ++n) *(LAS f32x4*)(halo + ((((2 * ai + wr) * 4 + wc) * 2 + ms) * 4 + fq) * 8 + 4 * n) = acc[ai][0][2 + ms][n];
            if (wr == 1) {
#pragma unroll
                for (int ms = 0; ms < 2; ++ms)
#pragma unroll
                    for (int n = 0; n < 2; ++n) *(f32x4*)(TAIL + ((size_t)u.pm * 2 + ms) * DFF + f0 + 4 * n) = acc[1][0][2 + ms][n]; }
        }
        if (fr == 0 && wr == 0) {
#pragma unroll
            for (int ms = 0; ms < 2; ++ms)
#pragma unroll
                for (int n = 0; n < 2; ++n) { *(f32x4*)(HEADG + ((size_t)u.pm * 2 + ms) * DFF + f0 + 4 * n) = acc[0][0][ms][n]; *(f32x4*)(HEADU + ((size_t)u.pm * 2 + ms) * DFF + f0 + 4 * n) = acc[0][1][ms][n]; } }
        asm volatile("s_waitcnt lgkmcnt(0)" ::: "memory"); __builtin_amdgcn_s_barrier(); asm volatile("" ::: "memory");
#pragma unroll
        for (int ai = 0; ai < 2; ++ai) { const int idx = 2 * ai + wr;
            f32x4 tm1[2], tm2[2];
#pragma unroll
            for (int n = 0; n < 2; ++n) { f32x4 h1, h2;
                if (idx > 0) { h1 = *(const LAS f32x4*)(halo + ((((idx - 1) * 4 + wc) * 2 + 1) * 4 + fq) * 8 + 4 * n); h2 = *(const LAS f32x4*)(halo + ((((idx - 1) * 4 + wc) * 2 + 0) * 4 + fq) * 8 + 4 * n); }
                else { h1 = (f32x4){0.f, 0.f, 0.f, 0.f}; h2 = h1; }
#pragma unroll
                for (int e = 0; e < 4; ++e) { tm1[n][e] = dpp_shr1(h1[e], acc[ai][0][3][n][e]); tm2[n][e] = dpp_shr1(h2[e], acc[ai][0][2][n][e]); } }
#pragma unroll
            for (int m = 0; m < 4; ++m) { f32x4 hv[2];
#pragma unroll
                for (int n = 0; n < 2; ++n) { const f32x4 cur = acc[ai][0][m][n];
                    const f32x4 p1 = m == 0 ? tm1[n] : acc[ai][0][m - 1][n], p2 = m == 0 ? tm2[n] : (m == 1 ? tm1[n] : acc[ai][0][m - 2][n]);
                    const f32x4 gp = w2[n] * cur + w1[n] * p1 + w0[n] * p2 + bv[n];
                    hv[n] = gelu4(gp) * acc[ai][1][m][n]; }
                st16b(H, H + h_idx(rowb, f0) + (ai * 128 + m) * 64, pack8(hv[0], hv[1])); } }
    }
};

struct EpiDown {
    static constexpr bool PERM = true, AFTER_DRAIN = false; static constexpr int VM_MIN = 40; static constexpr bool AROW4 = false, AMODES = false;
    const bf16_t* X1B; float* OUT;
    __device__ __forceinline__ void operator()(Acc& acc, const Unit& u, int wr, int wc, int fr, int fq) const {
        const size_t off0 = (size_t)(u.pm * 256 + wr * 64 + fr) * DM + 256 * u.pn + 32 * wc + 8 * fq;
#pragma unroll
        for (int ai = 0; ai < 2; ++ai) { u32x4 xq[4][2];
#pragma unroll
            for (int m = 0; m < 4; ++m)
#pragma unroll
                for (int bj = 0; bj < 2; ++bj) xq[m][bj] = *(const u32x4*)(X1B + off0 + (size_t)(ai * 128 + m * 16) * DM + 128 * bj);
            __builtin_amdgcn_sched_barrier(0);
#pragma unroll
            for (int m = 0; m < 4; ++m)
#pragma unroll
                for (int bj = 0; bj < 2; ++bj) { float* p = OUT + off0 + (size_t)(ai * 128 + m * 16) * DM + 128 * bj; f32x4 xa, xb; unpack8(xq[m][bj], xa, xb);
                    *(f32x4*)p = acc[ai][bj][m][0] + xa; *(f32x4*)(p + 4) = acc[ai][bj][m][1] + xb; } }
    }
};

__device__ __forceinline__ void p0_transpose_item(const float* W0, const float* W1, int ldw, int K, int Nphys, bf16_t* WT, const float* kscale, int mode, LAS float* scr, int item, int lane, float gmul = 1.0f) {
    const int nblk = Nphys / 32, kb = item / nblk, nb = item % nblk, k0 = 64 * kb, n0 = 32 * nb;
    const float* W = W0; int c0 = n0;
    float cm = 1.0f;
    if (mode == 1) { const int pn = n0 >> 8, p = n0 & 255; if (pn >= 2 && pn < 14) c0 = 256 * pn + 64 * ((p >> 5) & 3) + 32 * (p >> 7); if (pn >= 20) cm = gmul; }
    else if (mode == 2) { const int pn = n0 >> 8, p = n0 & 255; W = (p < 128) ? W0 : W1; c0 = 128 * pn + (p & 127); if (p >= 128) cm = gmul; }
    float wv[32];
#pragma unroll
    for (int i = 0; i < 32; ++i) wv[i] = W[(size_t)(k0 + 2 * i + (lane >> 5)) * ldw + c0 + (lane & 31)];
    if (kscale) {
#pragma unroll
        for (int i = 0; i < 32; ++i) wv[i] *= kscale[k0 + 2 * i + (lane >> 5)]; }
#pragma unroll
    for (int i = 0; i < 32; ++i) wv[i] *= cm;
#pragma unroll
    for (int i = 0; i < 32; ++i) scr[(2 * i + (lane >> 5)) * 33 + (lane & 31)] = wv[i];
    asm volatile("s_waitcnt lgkmcnt(0)" ::: "memory");
    const int c = lane & 7;
#pragma unroll
    for (int j = 0; j < 4; ++j) { const int n = (lane >> 3) + 8 * j; const LAS float* s = scr + (8 * c) * 33 + n;
        u32x4 o; o.x = cvt_pk_bf16(s[0 * 33], s[1 * 33]); o.y = cvt_pk_bf16(s[2 * 33], s[3 * 33]); o.z = cvt_pk_bf16(s[4 * 33], s[5 * 33]); o.w = cvt_pk_bf16(s[6 * 33], s[7 * 33]);
        *(u32x4*)(WT + (size_t)(n0 + n) * K + k0 + 8 * c) = o; }
    asm volatile("s_waitcnt lgkmcnt(0)" ::: "memory");
}

__device__ __forceinline__ double d_exp(double x) {
    const double n = __builtin_rint(x * 1.4426950408889634), r = __builtin_fma(-n, 1.9082149292705877e-10, __builtin_fma(-n, 0.6931471803691238, x));
    double p = 1.0 / 6227020800.0;
    p = __builtin_fma(p, r, 1.0 / 479001600.0); p = __builtin_fma(p, r, 1.0 / 39916800.0); p = __builtin_fma(p, r, 1.0 / 3628800.0); p = __builtin_fma(p, r, 1.0 / 362880.0);
    p = __builtin_fma(p, r, 1.0 / 40320.0); p = __builtin_fma(p, r, 1.0 / 5040.0); p = __builtin_fma(p, r, 1.0 / 720.0); p = __builtin_fma(p, r, 1.0 / 120.0);
    p = __builtin_fma(p, r, 1.0 / 24.0); p = __builtin_fma(p, r, 1.0 / 6.0); p = __builtin_fma(p, r, 0.5); p = __builtin_fma(p, r, 1.0); p = __builtin_fma(p, r, 1.0);
    const long long e = (long long)n + 1023; const double sc = __builtin_bit_cast(double, (unsigned long long)e << 52);
    return p * sc;
}
__device__ __forceinline__ void d_sincos(double x, double& s, double& c) {
    const double k = __builtin_rint(x * 0.6366197723675814); double r = __builtin_fma(-k, 1.5707963267948966, x); r = __builtin_fma(-k, 6.123233995736766e-17, r);
    const double r2 = r * r;
    double ps = -1.0 / 1307674368000.0; ps = __builtin_fma(ps, r2, 1.0 / 6227020800.0); ps = __builtin_fma(ps, r2, -1.0 / 39916800.0); ps = __builtin_fma(ps, r2, 1.0 / 362880.0);
    ps = __builtin_fma(ps, r2, -1.0 / 5040.0); ps = __builtin_fma(ps, r2, 1.0 / 120.0); ps = __builtin_fma(ps, r2, -1.0 / 6.0); ps = __builtin_fma(ps * r2, r, r);
    double pc = 1.0 / 20922789888000.0; pc = __builtin_fma(pc, r2, -1.0 / 87178291200.0); pc = __builtin_fma(pc, r2, 1.0 / 479001600.0); pc = __builtin_fma(pc, r2, -1.0 / 3628800.0);
    pc = __builtin_fma(pc, r2, 1.0 / 40320.0); pc = __builtin_fma(pc, r2, -1.0 / 720.0); pc = __builtin_fma(pc, r2, 1.0 / 24.0); pc = __builtin_fma(pc, r2, -0.5); pc = __builtin_fma(pc, r2, 1.0);
    const int q = (int)((long long)k & 3);
    s = (q == 0) ? ps : (q == 1) ? pc : (q == 2) ? -ps : -pc;
    c = (q == 0) ? pc : (q == 1) ? -ps : (q == 2) ? -pc : ps;
}
__device__ __forceinline__ void ssm_pow(const float* lam_re, const float* lam_im, const float* log_dt, int g, int p, int tau, bool times_coef, float& ore, float& oim) {
    const double dt = d_exp((double)log_dt[g]), lr = (double)lam_re[g * 64 + p], li = (double)lam_im[g * 64 + p];
    double s, c; d_sincos(li * dt * tau, s, c); const double mag = d_exp(lr * dt * tau); double wr = mag * c, wi = mag * s;
    if (times_coef) { double s1, c1; d_sincos(li * dt, s1, c1); const double m1 = d_exp(lr * dt), ar = m1 * c1, ai = m1 * s1, den = lr * lr + li * li;
        const double cr = ((ar - 1.0) * lr + ai * li) / den, ci = (ai * lr - (ar - 1.0) * li) / den; const double tr = wr * cr - wi * ci, ti = wr * ci + wi * cr; wr = tr; wi = ti; }
    ore = (float)wr; oim = (float)wi;
}
__device__ __forceinline__ void p0_toeplitz(const float* lam_re, const float* lam_im, const float* log_dt, const float* b_re, const float* b_im, const float* c_re, const float* c_im, const float* Dskip, bf16_t* TM, int g, int tau, int lane) {
    float wre, wim; ssm_pow(lam_re, lam_im, log_dt, g, lane, tau, true, wre, wim);
    const int co = lane >> 2, cq = lane & 3; float o0 = 0.f, o1 = 0.f, o2 = 0.f, o3 = 0.f;
    for (int p = 0; p < 64; ++p) { const float wr = __shfl(wre, p), wi = __shfl(wim, p);
        const float cr = c_re[(g * 16 + co) * 64 + p], ci = c_im[(g * 16 + co) * 64 + p]; const float xr = cr * wr - ci * wi, xi = cr * wi + ci * wr;
        const f32x4 br = *(const f32x4*)(b_re + (g * 64 + p) * 16 + 4 * cq), bi = *(const f32x4*)(b_im + (g * 64 + p) * 16 + 4 * cq);
        o0 += xr * br[0] - xi * bi[0]; o1 += xr * br[1] - xi * bi[1]; o2 += xr * br[2] - xi * bi[2]; o3 += xr * br[3] - xi * bi[3]; }
    if (tau == 0 && cq == (co >> 2)) { const float dv = Dskip[g * 16 + co]; const int k = co & 3;
        o0 += k == 0 ? dv : 0.f; o1 += k == 1 ? dv : 0.f; o2 += k == 2 ? dv : 0.f; o3 += k == 3 ? dv : 0.f; }
    u32x2 w; w.x = cvt_pk_bf16(o0, o1); w.y = cvt_pk_bf16(o2, o3); const u32x2 z = (u32x2){0u, 0u};
    bf16_t* base = TM + (size_t)g * 512 * U2LD + 128 + 4 * cq;
    for (int i = tau; i < CT; ++i) *(u32x2*)(base + (size_t)(16 * i + co) * U2LD + 16 * (i - tau)) = w;
    if (tau > 0) for (int i = 0; i + tau < CT; ++i) *(u32x2*)(base + (size_t)(16 * i + co) * U2LD + 16 * (i + tau)) = z;
}
__device__ __forceinline__ void p0_tstate(const float* lam_re, const float* lam_im, const float* log_dt, const float* c_re, const float* c_im, bf16_t* TM, int g, int i, int lane) {
    float er, ei; ssm_pow(lam_re, lam_im, log_dt, g, lane, i + 1, false, er, ei);
    for (int co = 0; co < 16; ++co) { const float cr = c_re[(g * 16 + co) * 64 + lane], ci = c_im[(g * 16 + co) * 64 + lane];
        bf16_t* row = TM + ((size_t)g * 512 + 16 * i + co) * U2LD; row[lane] = (bf16_t)f2bf(cr * er - ci * ei); row[64 + lane] = (bf16_t)f2bf(-(cr * ei + ci * er)); }
}
__device__ __forceinline__ void p0_hmat(const float* lam_re, const float* lam_im, const float* log_dt, const float* b_re, const float* b_im, bf16_t* HM, int g, int i, int lane) {
    float wr, wi; ssm_pow(lam_re, lam_im, log_dt, g, lane, CT - 1 - i, true, wr, wi);
    f32x4 br[4], bi[4];
#pragma unroll
    for (int j = 0; j < 4; ++j) { br[j] = *(const f32x4*)(b_re + (g * 64 + lane) * 16 + 4 * j); bi[j] = *(const f32x4*)(b_im + (g * 64 + lane) * 16 + 4 * j); }
    bf16_t* r0 = HM + ((size_t)g * 128 + lane) * 512 + 16 * i; bf16_t* r1 = r0 + (size_t)64 * 512;
    *(u32x4*)r0 = pack8(br[0] * wr - bi[0] * wi, br[1] * wr - bi[1] * wi); *(u32x4*)(r0 + 8) = pack8(br[2] * wr - bi[2] * wi, br[3] * wr - bi[3] * wi);
    *(u32x4*)r1 = pack8(br[0] * wi + bi[0] * wr, br[1] * wi + bi[1] * wr); *(u32x4*)(r1 + 8) = pack8(br[2] * wi + bi[2] * wr, br[3] * wi + bi[3] * wr);
}

__device__ __forceinline__ int crow(int r, int hi) { return (r & 3) + 8 * (r >> 2) + 4 * hi; }
struct AttTile { size_t hb; int rb, j0, tl0, dil, kt0, mode, b, hh, quarter; float slope2; };
__device__ __forceinline__ AttTile att_tile_params(int t, int wid, int vcu, int bx, int G) {
    AttTile P; const int ui = t / 6, rnd = (t % 6) >> 1, w = wid + 8 * (t & 1);
    int pair, quarter;
    if (G == 256) { pair = bx & 127; quarter = (bx >= 128) ? (ui == 0 ? 1 : 3) : (ui == 0 ? 2 : 0); }
    else { const int un = bx + ui * G; pair = un >> 2; quarter = un & 3; }
    P.b = pair >> 3; P.hh = pair & 7; P.quarter = quarter; P.mode = rnd;
    const int g = 2 - rnd;
    P.dil = rnd == 0 ? 16 : (rnd == 1 ? 4 : 1);
    if (rnd == 0) { P.rb = 128 * w; P.j0 = 32 * quarter; P.tl0 = w; }
    else if (rnd == 1) { const int r = w & 3, jb = w >> 2; P.rb = 512 * r; P.j0 = 128 * quarter + 32 * jb; P.tl0 = 128 * jb + r; }
    else { P.rb = 0; P.j0 = 512 * quarter + 32 * w; P.tl0 = 32 * w; }
    P.hb = (size_t)(P.b * NHEADS + 8 * g + P.hh) * SEQ * HD;
    P.kt0 = (P.j0 >= 128) ? 0 : 4 - (P.j0 >> 5);
    P.slope2 = __builtin_amdgcn_exp2f(-(float)(3 * P.hh + g + 1) * (1.0f / 3.0f)) * (float)P.dil * LOG2E;
    return P;
}
__device__ __forceinline__ void attn_phase(const bf16_t* Qb, const bf16_t* Kb, const bf16_t* Vb, bf16_t* OATT, LAS unsigned char* lds, float m0, int ntiles, int wid, int lane, int vcu, int bx, int G) {
    LAS unsigned char* nums = lds; LAS float* dens = (LAS float*)(lds + 65536); LAS unsigned char* vb = lds + 67584 + wid * VT_BYTES;
    const int q = lane & 31, hi = lane >> 5;
    const int vlo = hi * 256 + ((q & 7) * 4 + (q >> 3)) * 8;
    AttTile P = att_tile_params(0, wid, vcu, bx, G);
    bf16x8 qf[4], qn[4], kf[4]; u32x4 vv[4];
#define ATT_LOADQ(QF, PP) do { const bf16_t* qp_ = Qb + (PP).hb + (size_t)((PP).rb + (PP).j0) * HD + lane * 8; \
        _Pragma("unroll") for (int ks = 0; ks < 4; ++ks) QF[ks] = *(const bf16x8*)(qp_ + ks * 512); } while (0)
#define ATT_LOADKV(PP, KT) do { const int k0_ = (PP).j0 - 128 + 32 * (KT); const bf16_t* kp_ = Kb + (PP).hb + (size_t)((PP).rb + k0_) * HD + lane * 8; \
        _Pragma("unroll") for (int ks = 0; ks < 4; ++ks) kf[ks] = *(const bf16x8*)(kp_ + ks * 512); \
        const bf16_t* vp_ = Vb + (PP).hb + (size_t)((PP).rb + k0_) * HD + vlo; \
        _Pragma("unroll") for (int c = 0; c < 4; ++c) vv[c] = *(const u32x4*)(vp_ + c * 512); } while (0)
    ATT_LOADQ(qf, P); ATT_LOADKV(P, P.kt0);
#pragma unroll 1
    for (int t = 0; t < ntiles; ++t) {
        const AttTile Pn = att_tile_params(t + 1 < ntiles ? t + 1 : t, wid, vcu, bx, G);
        if (t > 0 && (t & 1) == 0) { asm volatile("s_waitcnt lgkmcnt(0)" ::: "memory"); __builtin_amdgcn_s_barrier(); asm volatile("" ::: "memory"); }
        const int tl = P.tl0 + q * P.dil;
        LAS unsigned char* np = nums + tl * 128 + 8 * hi;
        const int nsw = ((tl ^ (tl >> 2) ^ (tl >> 4)) & 7) * 16;
        f32x16 o0 = {}, o1 = {}; float den = 0.f;
        if (P.mode != 0) {
            if (hi == 0) den = dens[tl];
#pragma unroll
            for (int rq = 0; rq < 4; ++rq) { const u32x2 a = *(const LAS u32x2*)(np + ((16 * rq) ^ nsw)), b = *(const LAS u32x2*)(np + ((64 + 16 * rq) ^ nsw));
                o0[4 * rq] = bf_lo(a.x); o0[4 * rq + 1] = bf_hi(a.x); o0[4 * rq + 2] = bf_lo(a.y); o0[4 * rq + 3] = bf_hi(a.y);
                o1[4 * rq] = bf_lo(b.x); o1[4 * rq + 1] = bf_hi(b.x); o1[4 * rq + 2] = bf_lo(b.y); o1[4 * rq + 3] = bf_hi(b.y); }
        }
#pragma unroll 1
        for (int kt = P.kt0; kt <= 4; ++kt) {
            f32x16 s = {};
#pragma unroll
            for (int ks = 0; ks < 4; ++ks) s = __builtin_amdgcn_mfma_f32_32x32x16_bf16(kf[ks], qf[ks], s, 0, 0, 0);
            u32x4 vc[4];
#pragma unroll
            for (int c = 0; c < 4; ++c) vc[c] = vv[c];
            { const bool last = kt == 4; const size_t hbn = last ? Pn.hb : P.hb; const int rown = last ? Pn.rb + Pn.j0 - 128 + 32 * Pn.kt0 : P.rb + P.j0 - 128 + 32 * (kt + 1);
              const bf16_t* kp_ = Kb + hbn + (size_t)rown * HD + lane * 8;
#pragma unroll
              for (int ks = 0; ks < 4; ++ks) kf[ks] = *(const bf16x8*)(kp_ + ks * 512);
              const bf16_t* vp_ = Vb + hbn + (size_t)rown * HD + vlo;
#pragma unroll
              for (int c = 0; c < 4; ++c) vv[c] = *(const u32x4*)(vp_ + c * 512);
              if (last) ATT_LOADQ(qn, Pn); }
            __builtin_amdgcn_sched_barrier(0);
            const int dq = 128 - 32 * kt + q;
            const float base = -P.slope2 * (float)dq - m0;
            float p[16];
#pragma unroll
            for (int rr = 0; rr < 16; ++rr) { const int key = crow(rr, hi); float v = s[rr] + base + P.slope2 * (float)key;
                if (kt == 0) { if (dq - key > 128) v = -__builtin_inff(); }
                if (kt == 4) { if (dq - key < 0) v = -__builtin_inff(); }
                p[rr] = __builtin_amdgcn_exp2f(v); den += p[rr]; }
            u32x4 pw0, pw1;
            pw0.x = cvt_pk_bf16(p[0], p[1]); pw0.y = cvt_pk_bf16(p[2], p[3]); pw0.z = cvt_pk_bf16(p[4], p[5]); pw0.w = cvt_pk_bf16(p[6], p[7]);
            pw1.x = cvt_pk_bf16(p[8], p[9]); pw1.y = cvt_pk_bf16(p[10], p[11]); pw1.z = cvt_pk_bf16(p[12], p[13]); pw1.w = cvt_pk_bf16(p[14], p[15]);
            const bf16x8 pb0 = __builtin_bit_cast(bf16x8, pw0), pb1 = __builtin_bit_cast(bf16x8, pw1);
#pragma unroll
            for (int db = 0; db < 2; ++db)
#pragma unroll
                for (int sk = 0; sk < 2; ++sk) {
                    const bf16x8 vf = __builtin_bit_cast(bf16x8, vc[db * 2 + sk]);
                    if (db == 0) o0 = __builtin_amdgcn_mfma_f32_32x32x16_bf16(vf, sk == 0 ? pb0 : pb1, o0, 0, 0, 0);
                    else         o1 = __builtin_amdgcn_mfma_f32_32x32x16_bf16(vf, sk == 0 ? pb0 : pb1, o1, 0, 0, 0);
                }
        }
        den += __shfl_xor(den, 32);
        if (P.mode != 2) {
            if (hi == 0) dens[tl] = den;
#pragma unroll
            for (int db = 0; db < 2; ++db)
#pragma unroll
                for (int rq = 0; rq < 4; ++rq) { u32x2 w; const f32x16& o = db == 0 ? o0 : o1; w.x = cvt_pk_bf16(o[4 * rq], o[4 * rq + 1]); w.y = cvt_pk_bf16(o[4 * rq + 2], o[4 * rq + 3]); *(LAS u32x2*)(np + ((db * 64 + 16 * rq) ^ nsw)) = w; }
        } else {
            const float inv = __builtin_amdgcn_rcpf(den);
#pragma unroll
            for (int db = 0; db < 2; ++db)
#pragma unroll
                for (int rq = 0; rq < 4; ++rq) { u32x2 w; const f32x16& o = db == 0 ? o0 : o1; w.x = cvt_pk_bf16(o[4 * rq] * inv, o[4 * rq + 1] * inv); w.y = cvt_pk_bf16(o[4 * rq + 2] * inv, o[4 * rq + 3] * inv);
                    *(LAS u32x2*)(vb + q * 128 + db * 64 + 16 * rq + 8 * hi) = w; }
            const int orow = P.b * SEQ + 512 * P.quarter + P.tl0;
#pragma unroll
            for (int c = 0; c < 4; ++c) { const int x = c * 64 + lane, r_ = x >> 3; const u32x4 v = *(const LAS u32x4*)(vb + r_ * 128 + (x & 7) * 16);
                *(u32x4*)(OATT + blk_idx<AOUT>(orow + r_, P.hh * 64 + (x & 7) * 8)) = v; }
        }
#pragma unroll
        for (int ks = 0; ks < 4; ++ks) qf[ks] = qn[ks];
        P = Pn;
    }
#undef ATT_LOADQ
#undef ATT_LOADKV
}

#define XB_TMO      128
#define XB_XCNT(j)  (256  + 64 * (j))
#define XB_XSUB(j)  (1280 + 64 * (j))
#define XB_XGEN(j)  (2304 + 64 * (j))
#define XB_TOP      3328
#define XB_TOPGEN   3392
#define XCD_BAR_WORDS 3456
#define XB_SPIN_CAP (1u << 18)

__device__ __forceinline__ unsigned xb_ld(unsigned* p)              { return __hip_atomic_load(p, __ATOMIC_RELAXED, __HIP_MEMORY_SCOPE_AGENT); }
__device__ __forceinline__ unsigned xb_add(unsigned* p, unsigned v) { return __hip_atomic_fetch_add(p, v, __ATOMIC_RELAXED, __HIP_MEMORY_SCOPE_AGENT); }
__device__ __forceinline__ unsigned xb_xcc_id() { return (unsigned)__builtin_amdgcn_s_getreg((3 << 11) | 20) & 0xFu; }
#define XB_SPIN(cond, bar) do { unsigned _sp = 0; while (cond) { __builtin_amdgcn_s_sleep(1); \
    if ((++_sp & 255u) == 0u) { if (xb_ld(&(bar)[XB_TMO])) break; if (_sp > XB_SPIN_CAP) { atomicAdd(&(bar)[XB_TMO], 1u); break; } } } } while (0)

struct XcdBarrier {
    unsigned* bar; unsigned x;
    volatile LAS unsigned* st;
};

__device__ __forceinline__ XcdBarrier xcd_barrier_post(unsigned* bar, volatile LAS unsigned* st) {
    XcdBarrier b; b.bar = bar; b.x = xb_xcc_id(); b.st = st;
    if (threadIdx.x == 0) (void)xb_add(&bar[XB_XCNT(b.x)], 1u);
    return b;
}
__device__ __forceinline__ void xcd_barrier_complete(unsigned* bar, unsigned x, unsigned& nloc, unsigned& nx) {
    const unsigned G = gridDim.x * gridDim.y * gridDim.z;
    unsigned sum, cnt, mine, sp = 0u;
    for (;;) {
        sum = 0u; cnt = 0u; mine = 0u;
#pragma unroll
        for (unsigned j = 0; j < 16; ++j) { const unsigned c = xb_ld(&bar[XB_XCNT(j)]); sum += c; cnt += (c > 0u) ? 1u : 0u; mine = (j == x) ? c : mine; }
        if (sum == G) break;
        __builtin_amdgcn_s_sleep(1);
        if ((++sp & 255u) == 0u) { if (xb_ld(&bar[XB_TMO])) break; if (sp > XB_SPIN_CAP) { atomicAdd(&bar[XB_TMO], 1u); break; } }
    }
    nloc = mine > 0u ? mine : 1u; nx = cnt > 0u ? cnt : 1u;
}

__device__ __forceinline__ void xcd_barrier(const XcdBarrier& b) {
    asm volatile("s_waitcnt vmcnt(0)" ::: "memory");
    __syncthreads();
    if (threadIdx.x == 0) {
        unsigned* bar = b.bar;
        __builtin_amdgcn_s_waitcnt(0);
        unsigned nloc = b.st[0], nx = b.st[1];
        if (nloc == 0u) { xcd_barrier_complete(bar, b.x, nloc, nx); b.st[0] = nloc; b.st[1] = nx; }
        const unsigned old = xb_add(&bar[XB_XSUB(b.x)], 1u);
        const unsigned gen = old / nloc;
        if (old + 1u == (gen + 1u) * nloc) {
            __builtin_amdgcn_fence(__ATOMIC_RELEASE, "agent");
            asm volatile("s_waitcnt vmcnt(0)" ::: "memory");
            const unsigned og = xb_add(&bar[XB_TOP], 1u);
            const unsigned tg = og / nx;
            if (og + 1u == (tg + 1u) * nx) xb_add(&bar[XB_TOPGEN], 1u);
            else XB_SPIN(xb_ld(&bar[XB_TOPGEN]) == tg, bar);
            __builtin_amdgcn_fence(__ATOMIC_ACQUIRE, "agent");
            xb_add(&bar[XB_XGEN(b.x)], 1u);
            asm volatile("s_waitcnt vmcnt(0)" ::: "memory");
        } else {
            XB_SPIN(xb_ld(&bar[XB_XGEN(b.x)]) == gen, bar);
            __builtin_amdgcn_fence(__ATOMIC_ACQUIRE, "agent");
            asm volatile("s_waitcnt vmcnt(0)" ::: "memory");
        }
    }
    __syncthreads();
}

struct Args {
    const float* in[23]; float* out; unsigned char* ws; int ph_lo, ph_hi;
};
enum { I_X = 0, I_NMG, I_WIN, I_LRE, I_LIM, I_LDT, I_BRE, I_BIM, I_CRE, I_CIM, I_D, I_GLV, I_GLG, I_QG, I_KG, I_WUP, I_WOUT, I_NFG, I_FWG, I_FWU, I_CW, I_CB, I_WDN };
constexpr int NPHASE = 8;
#ifndef MK_COOP
#define MK_COOP 1
#endif

__global__ void __launch_bounds__(512, 2) hybrid_fwd(Args args) {
    extern __shared__ __attribute__((aligned(16))) unsigned char lds_raw[];
    LAS unsigned char* lds = (LAS unsigned char*)lds_raw;
    const int tid = threadIdx.x, lane = tid & 63, wid = __builtin_amdgcn_readfirstlane(tid >> 6);
    const int G = gridDim.x, bx = blockIdx.x, vcu = (G % 8 == 0) ? (bx % 8) * (G / 8) + bx / 8 : bx;
    unsigned char* ws = args.ws; unsigned char* dob = (unsigned char*)args.out;
    const int lo = args.ph_lo, hi = args.ph_hi;
    volatile LAS unsigned* MISC = (volatile LAS unsigned*)(lds + LDS_MISC);
    if (tid < 16) MISC[tid] = 0u;
    __syncthreads();
    XcdBarrier bar; bar.bar = (unsigned*)ws; bar.x = 0; bar.st = nullptr;
#if MK_COOP
    bar = xcd_barrier_post((unsigned*)ws, MISC);
#endif
#define IN(k) (lo <= (k) && (k) < hi)
#if MK_COOP
#define SEAM(k) do { if (IN(k) && IN((k) + 1)) { xcd_barrier(bar); } } while (0)
#else
#define SEAM(k) do { } while (0)
#endif
    bf16_t* const WIN = (bf16_t*)(ws + WS_WIN); bf16_t* const WGLU = (bf16_t*)(ws + WS_WGLU); bf16_t* const WUP = (bf16_t*)(ws + WS_WUP); bf16_t* const WOUT = (bf16_t*)(ws + WS_WOUT);
    bf16_t* const WGU = (bf16_t*)(ws + WS_WGU); bf16_t* const WDN = (bf16_t*)(ws + WS_WDN); bf16_t* const TMAT = (bf16_t*)(ws + WS_TMAT); bf16_t* const HMAT = (bf16_t*)(ws + WS_HMAT);
    float* const SS = (float*)(ws + WS_SS); f32x2* const APOW = (f32x2*)(ws + WS_APOW);
    bf16_t* const GA = (bf16_t*)(ws + WS_GA); bf16_t* const GB = (bf16_t*)(ws + WS_GB);
    bf16_t* const Qb = (bf16_t*)(ws + WS_Q); bf16_t* const Kb = (bf16_t*)(ws + WS_K); bf16_t* const Vb = (bf16_t*)(ws + WS_V);
    bf16_t* const YSSM = (bf16_t*)(ws + WS_YSSM); bf16_t* const TMPB = (bf16_t*)(ws + WS_TMPB); bf16_t* const MERGED = (bf16_t*)(ws + WS_MERGED); bf16_t* const X1B = (bf16_t*)(ws + WS_X1B); bf16_t* const HB = (bf16_t*)(ws + WS_H);
    float* const TAIL = (float*)(ws + WS_TAIL); float* const HEADG = (float*)(ws + WS_HEADG); float* const HEADU = (float*)(ws + WS_HEADU);
    bf16_t* const XN = (bf16_t*)(dob + DO_XN); bf16_t* const U2 = (bf16_t*)(dob + DO_U2); bf16_t* const OATT = (bf16_t*)(ws + WS_GA + 32 * MiB);
    float* const RINV = (float*)(ws + WS_RINV);
    float* const OUT = args.out;

    if (IN(0)) {
        LAS float* scr = (LAS float*)(lds + wid * 16384);
        const bool swv = wid < 5; const int gw = swv ? vcu * 5 + wid : vcu * 3 + (wid - 5), NGW = swv ? G * 5 : G * 3;
        constexpr int XSPLIT = 3 * MTOK / 4;
        constexpr int I_IN = 16 * (NIN / 32), I_GL = 8 * (2048 / 32), I_UP = 8 * (1024 / 32), I_OU = 16 * (1024 / 32), I_GU = 16 * (2 * DFF / 32), I_DN = (DFF / 64) * (1024 / 32);
        constexpr int NW = I_IN + I_GL + I_UP + I_OU + I_GU + I_DN;
        for (int it = swv ? NW : gw; it < NW; it += NGW) {
            int r = it;
            if (r < I_IN) { p0_transpose_item(args.in[I_WIN], nullptr, NIN, DM, NIN, WIN, args.in[I_NMG], 1, scr, r, lane, -LOG2E); continue; } r -= I_IN;
            if (r < I_GL) { p0_transpose_item(args.in[I_GLV], args.in[I_GLG], DM, SSMW, 2048, WGLU, nullptr, 2, scr, r, lane, -LOG2E); continue; } r -= I_GL;
            if (r < I_UP) { p0_transpose_item(args.in[I_WUP], nullptr, DM, AOUT, DM, WUP, nullptr, 0, scr, r, lane); continue; } r -= I_UP;
            if (r < I_OU) { p0_transpose_item(args.in[I_WOUT], nullptr, DM, DM, DM, WOUT, nullptr, 0, scr, r, lane); continue; } r -= I_OU;
            if (r < I_GU) { p0_transpose_item(args.in[I_FWG], args.in[I_FWU], DFF, DM, 2 * DFF, WGU, args.in[I_NFG], 2, scr, r, lane); continue; } r -= I_GU;
            p0_transpose_item(args.in[I_WDN], nullptr, DM, DFF, DM, WDN, nullptr, 0, scr, r, lane);
        }
        for (int it = swv ? gw : 3 * 1024 + 32 + 1; it < 3 * 1024 + 32 + 1; it += NGW) {
            if (it < 1024) p0_toeplitz(args.in[I_LRE], args.in[I_LIM], args.in[I_LDT], args.in[I_BRE], args.in[I_BIM], args.in[I_CRE], args.in[I_CIM], args.in[I_D], TMAT, it >> 5, it & 31, lane);
            else if (it < 2048) p0_tstate(args.in[I_LRE], args.in[I_LIM], args.in[I_LDT], args.in[I_CRE], args.in[I_CIM], TMAT, (it - 1024) >> 5, it & 31, lane);
            else if (it < 3072) p0_hmat(args.in[I_LRE], args.in[I_LIM], args.in[I_LDT], args.in[I_BRE], args.in[I_BIM], HMAT, (it - 2048) >> 5, it & 31, lane);
            else if (it < 3104) { float ar, ai; ssm_pow(args.in[I_LRE], args.in[I_LIM], args.in[I_LDT], it - 3072, lane, CT, false, ar, ai); APOW[(it - 3072) * 64 + lane] = (f32x2){ar, ai}; }
            else { for (int j = lane; j < 128 * 512 / 8; j += 64) *(u32x4*)(HMAT + (size_t)32 * 128 * 512 + (size_t)j * 8) = (u32x4){0u, 0u, 0u, 0u}; }
        }
        for (int j = vcu * 512 + tid; j < MTOK; j += G * 512) SS[j] = 0.f;
        const float* X = args.in[I_X];
        for (int m0 = (swv ? XSPLIT : 0) + gw * 4; m0 < (swv ? MTOK : XSPLIT); m0 += NGW * 4) {
            f32x4 v[4][4]; float s[4];
#pragma unroll
            for (int rr = 0; rr < 4; ++rr) { const f32x4* xr = (const f32x4*)(X + (size_t)(m0 + rr) * DM) + lane;
#pragma unroll
                for (int j = 0; j < 4; ++j) v[rr][j] = xr[64 * j]; }
#pragma unroll
            for (int rr = 0; rr < 4; ++rr) { float a = 0.f;
#pragma unroll
                for (int j = 0; j < 4; ++j) a += (v[rr][j][0] * v[rr][j][0] + v[rr][j][1] * v[rr][j][1]) + (v[rr][j][2] * v[rr][j][2] + v[rr][j][3] * v[rr][j][3]);
                s[rr] = a; }
#pragma unroll
            for (int o = 1; o < 64; o <<= 1) {
#pragma unroll
                for (int rr = 0; rr < 4; ++rr) s[rr] += __shfl_xor(s[rr], o); }
#pragma unroll
            for (int rr = 0; rr < 4; ++rr) { const float rs = __builtin_amdgcn_rsqf(s[rr] * (1.0f / DM) + EPS); u32x2* o = (u32x2*)(XN + (size_t)(m0 + rr) * DM) + lane;
                if (lane == 0) RINV[m0 + rr] = __builtin_sqrtf(s[rr] * (1.0f / DM) + EPS);
#pragma unroll
                for (int j = 0; j < 4; ++j) { u32x2 w; w.x = cvt_pk_bf16(v[rr][j][0] * rs, v[rr][j][1] * rs); w.y = cvt_pk_bf16(v[rr][j][2] * rs, v[rr][j][3] * rs); o[64 * j] = w; } }
        }
        asm volatile("s_waitcnt vmcnt(0) lgkmcnt(0)" ::: "memory"); __syncthreads();
    }
    SEAM(0);

    if (IN(1)) {
        pg8::Gemm g{XN, WIN, DM, DM, DM}; pg8::StaticOrder<0> S; S.init(MTOK / 256, NIN / 256, G, bx);
        S.inproj = true;
        EpiInProj E{U2, Qb, Kb, Vb, GA, GB, args.in[I_QG], args.in[I_KG]};
        pg8::gemm_phase<EpiInProj, pg8::StaticOrder<0>, true, true>(lds, g, S, E);
    }
    SEAM(1);

    if (IN(2)) {
        { pg8::Gemm g{U2 + 128, HMAT, CT * GCH, U2LD, CT * GCH}; pg8::StaticOrder<1> S; S.init(128, 1, G, bx);
          EpiSsmState E{U2, APOW};
          pg8::gemm_phase<EpiSsmState, pg8::StaticOrder<1>, false, true>(lds, g, S, E); }
        __syncthreads();
        const float m0 = 8.0f * LOG2E * wave_max(fabsf(args.in[I_QG][lane])) * wave_max(fabsf(args.in[I_KG][lane]));
        const int nun = (G == 256) ? 2 : (512 - bx + G - 1) / G;
        attn_phase(Qb, Kb, Vb, OATT, lds, m0, 6 * nun, wid, lane, vcu, bx, G);
        asm volatile("s_waitcnt vmcnt(0) lgkmcnt(0)" ::: "memory"); __syncthreads();
    }
    SEAM(2);

    if (IN(3)) {
        { pg8::Gemm g{U2, TMAT, U2LD, U2LD, U2LD}; pg8::StaticOrder<2> S; S.init(128, 2, G, bx);
          EpiSsmOut E{YSSM};
          pg8::gemm_phase<EpiSsmOut, pg8::StaticOrder<2>, true, true>(lds, g, S, E); }
        __syncthreads();
        { pg8::Gemm g{OATT, WUP, AOUT, AOUT, AOUT, 1}; pg8::StaticOrder<0> S; S.init(MTOK / 256, DM / 256, G, bx);
          EpiUp E{GB, TMPB};
          pg8::gemm_phase<EpiUp, pg8::StaticOrder<0>, true, true>(lds, g, S, E); }
    }
    SEAM(3);

    if (IN(4)) {
        pg8::Gemm g{YSSM, WGLU, SSMW, SSMW, SSMW, 1}; pg8::StaticOrder<0> S; S.init(MTOK / 256, 2048 / 256, G, bx);
        EpiGlu E{GA, TMPB, MERGED};
        pg8::gemm_phase<EpiGlu, pg8::StaticOrder<0>, true, true>(lds, g, S, E);
    }
    SEAM(4);

    if (IN(5)) {
        pg8::Gemm g{MERGED, WOUT, DM, DM, DM, 1}; pg8::StaticOrder<0> S; S.init(MTOK / 256, DM / 256, G, bx);
        EpiOut E{XN, RINV, X1B, SS};
        pg8::gemm_phase<EpiOut, pg8::StaticOrder<0>, true, true>(lds, g, S, E);
    }
    SEAM(5);

    if (IN(6)) {
        pg8::Gemm g{X1B, WGU, DM, DM, DM}; pg8::StaticOrder<0> S; S.init(MTOK / 256, 2 * DFF / 256, G, bx);
        EpiFfn E{SS, args.in[I_CW], args.in[I_CB], HB, TAIL, HEADG, HEADU, (LAS float*)(lds + LDS_HALO)};
        pg8::gemm_phase<EpiFfn, pg8::StaticOrder<0>, true, true>(lds, g, S, E);
    }
    SEAM(6);

    if (IN(7)) {
        pg8::Gemm g{HB, WDN, DFF, DFF, DFF, 1}; pg8::StaticOrder<0> S; S.init(MTOK / 256, DM / 256, G, bx);
        { const float* cw = args.in[I_CW]; const float* cb = args.in[I_CB]; pg8::Unit uu;
          for (int i = 0; S.next(i, uu); ++i) { const int pm = uu.pm; if ((pm & 7) == 0) continue;
            for (int f = tid; f < DFF; f += 512) {
                const float g0 = HEADG[((size_t)pm * 2) * DFF + f], g1 = HEADG[((size_t)pm * 2 + 1) * DFF + f], ta = TAIL[((size_t)(pm - 1) * 2) * DFF + f], tb = TAIL[((size_t)(pm - 1) * 2 + 1) * DFF + f];
                const float w0 = cw[f], w1 = cw[DFF + f], w2 = cw[2 * DFF + f], bb = cb[f];
                const f32x2 gl = gelu_pk((f32x2){w2 * g0 + w1 * tb + w0 * ta + bb, w2 * g1 + w1 * g0 + w0 * tb + bb});
                HB[h_idx(pm * 256, f)] = (bf16_t)f2bf(gl.x * HEADU[((size_t)pm * 2) * DFF + f]);
                HB[h_idx(pm * 256 + 1, f)] = (bf16_t)f2bf(gl.y * HEADU[((size_t)pm * 2 + 1) * DFF + f]); } }
          asm volatile("s_waitcnt vmcnt(0)" ::: "memory"); __syncthreads(); }
        EpiDown E{X1B, OUT};
        pg8::gemm_phase<EpiDown, pg8::StaticOrder<0>, true, true>(lds, g, S, E);
    }
#undef IN
#undef SEAM
}

extern "C" void kernel_launch(void* const* d_in, const int* in_sizes, int n_in, void* d_out, int out_size, void* d_ws, size_t ws_size, hipStream_t stream) {
    static int grid = 0;
    if (grid == 0) {
        if (n_in != 23 || out_size != MTOK * DM || ws_size < WS_END) { fprintf(stderr, "kernel_launch: unexpected problem (n_in %d, out %d, ws %zu < %zu)\n", n_in, out_size, ws_size, (size_t)WS_END); grid = -1; return; }
        int dev = 0, cus = 0, per_cu = 0;
        (void)hipGetDevice(&dev); (void)hipDeviceGetAttribute(&cus, hipDeviceAttributeMultiprocessorCount, dev);
        if (hipFuncSetAttribute((const void*)hybrid_fwd, hipFuncAttributeMaxDynamicSharedMemorySize, LDS_BYTES) != hipSuccess) { fprintf(stderr, "kernel_launch: hipFuncSetAttribute failed\n"); grid = -1; return; }
        if (hipOccupancyMaxActiveBlocksPerMultiprocessor(&per_cu, (const void*)hybrid_fwd, 512, LDS_BYTES) != hipSuccess || per_cu < 1) { fprintf(stderr, "kernel_launch: the occupancy query admits %d workgroups per CU for this kernel and LDS size; the grid barrier needs one resident workgroup per CU; nothing launched\n", per_cu); grid = -1; return; }
        (void)hipGetLastError();
        grid = cus;
        if (grid != 256) fprintf(stderr, "kernel_launch: %d CUs (expected 256)\n", grid);
        if (grid < 128) { fprintf(stderr, "kernel_launch: the S5 chunk-state phase needs at least 128 workgroups (one unit each); nothing launched\n"); grid = -1; return; }
    }
    if (grid < 0) return;
    Args a{};
    for (int i = 0; i < 23; ++i) a.in[i] = (const float*)d_in[i];
    a.out = (float*)d_out; a.ws = (unsigned char*)d_ws;
#if MK_COOP
    if (hipMemsetAsync(d_ws, 0, 16384, stream) != hipSuccess) { fprintf(stderr, "kernel_launch: memset of the barrier words failed\n"); return; }
    a.ph_lo = 0; a.ph_hi = NPHASE;
    void* kargs[] = {&a};
    hipError_t e = hipLaunchCooperativeKernel((const void*)hybrid_fwd, dim3(grid), dim3(512), kargs, LDS_BYTES, stream);
    if (e != hipSuccess) fprintf(stderr, "kernel_launch: cooperative launch failed: %s (grid %d)\n", hipGetErrorString(e), grid);
#else
    for (int ph = 0; ph < NPHASE; ++ph) { a.ph_lo = ph; a.ph_hi = ph + 1; hipLaunchKernelGGL(hybrid_fwd, dim3(grid), dim3(512), LDS_BYTES, stream, a); }
#endif
}
```
